# Optimizing an MI355X kernel written in HIP

```python
import math
import jax, jax.numpy as jnp
from jax import lax
import numpy as np

D_MODEL = 1024
BATCH = 2
SEQ = 16384
DEPTH = 1
DEC_BATCH = 16
DEC_SEQ = 4096
PAST_LEN = 128

A_HEADS = 8
A_HEAD_DIM = 64
A_V_DIM = 2 * A_HEAD_DIM
A_QK = 2 * A_HEADS * A_HEAD_DIM
A_WIDTH = A_HEADS * A_V_DIM
Q_BLOCK = 128
B_GROUPS = 8
B_WIDTH = 1024
B_GROUP_DIM = B_WIDTH // B_GROUPS
CHUNK = 128
REL_BUCKETS = 32
REL_MAX_DIST = 128
EPS = 1e-6

IN_SIZES = (A_QK, A_QK, A_WIDTH, A_WIDTH, B_WIDTH, B_WIDTH, B_WIDTH, D_MODEL, D_MODEL)
IN_COLS = sum(IN_SIZES)
IN_SPLITS = tuple(int(s) for s in np.cumsum(IN_SIZES)[:-1])

kernel_name = "hybrid_diffattn_gmlp_gated_encoder"


def rms_norm(x, g):
    xf = x.astype(jnp.float32)
    y = xf * lax.rsqrt(jnp.mean(xf * xf, axis=-1, keepdims=True) + EPS) * g.astype(jnp.float32)
    return y.astype(x.dtype)


def layer_norm(x, g, b):
    xf = x.astype(jnp.float32)
    mu = jnp.mean(xf, axis=-1, keepdims=True)
    xc = xf - mu
    y = xc * lax.rsqrt(jnp.mean(xc * xc, axis=-1, keepdims=True) + EPS)
    return (y * g.astype(jnp.float32) + b.astype(jnp.float32)).astype(x.dtype)


def rel_bucket(rel):
    half = REL_BUCKETS // 2
    max_exact = half // 2
    n = jnp.abs(rel)
    nf = jnp.maximum(n, 1).astype(jnp.float32)
    large = max_exact + (jnp.log(nf / max_exact) / math.log(REL_MAX_DIST / max_exact)
                         * (half - max_exact)).astype(jnp.int32)
    large = jnp.minimum(large, half - 1)
    return jnp.where(rel > 0, half, 0) + jnp.where(n < max_exact, n, large)


def diff_attention(q1, q2, k1, k2, v, lam, rel_bias):
    B, S, H, d = q1.shape
    nblk = S // Q_BLOCK
    scale = d ** -0.5
    kpos = jnp.arange(S)
    table = rel_bias.astype(jnp.float32)

    def to_blocks(t):
        return t.reshape(B, nblk, Q_BLOCK, H, d).swapaxes(0, 1)

    def one_block(args):
        i, a1, a2 = args
        qpos = i * Q_BLOCK + jnp.arange(Q_BLOCK)
        bias = table[rel_bucket(kpos[None, :] - qpos[:, None])].transpose(2, 0, 1)
        s1 = jnp.einsum('bqhd,bkhd->bhqk', a1, k1, preferred_element_type=jnp.float32) * scale + bias
        s2 = jnp.einsum('bqhd,bkhd->bhqk', a2, k2, preferred_element_type=jnp.float32) * scale + bias
        p = jax.nn.softmax(s1, axis=-1) - lam * jax.nn.softmax(s2, axis=-1)
        return jnp.einsum('bhqk,bkhe->bqhe', p.astype(v.dtype), v)

    o = lax.map(one_block, (jnp.arange(nblk), to_blocks(q1), to_blocks(q2)))
    return o.swapaxes(0, 1).reshape(B, S, H, v.shape[-1])


def spatial_gate(u, v, ln_g, ln_b, w_s, b_s):
    B, S, _ = v.shape
    vn = layer_norm(v, ln_g, ln_b).reshape(B, S // CHUNK, CHUNK, B_GROUPS, B_GROUP_DIM)
    s = jnp.einsum('gpq,bcqgk->bcpgk', w_s, vn) + b_s.T[None, None, :, :, None]
    return u * s.reshape(B, S, B_WIDTH)


def encoder_layer(x, layer_idx, g_pre, w_in, lambda_q1, lambda_k1, lambda_q2, lambda_k2, subln_g,
                  w_pa, ln_g, ln_b, w_s, b_s, w_pb, w_o, g_post, rel_bias):
    B, S, _ = x.shape
    lambda_init = 0.8 - 0.6 * math.exp(-0.3 * layer_idx)
    h = rms_norm(x, g_pre)
    z = h @ w_in
    q, k, v_a, gate_a, u_b, v_b, gate_b, m_a, m_b = jnp.split(z, IN_SPLITS, axis=-1)
    q = q.reshape(B, S, 2, A_HEADS, A_HEAD_DIM)
    k = k.reshape(B, S, 2, A_HEADS, A_HEAD_DIM)
    v_a = v_a.reshape(B, S, A_HEADS, A_V_DIM)
    lam = (jnp.exp(jnp.sum(lambda_q1.astype(jnp.float32) * lambda_k1.astype(jnp.float32)))
           - jnp.exp(jnp.sum(lambda_q2.astype(jnp.float32) * lambda_k2.astype(jnp.float32)))
           + lambda_init)
    o = diff_attention(q[:, :, 0], q[:, :, 1], k[:, :, 0], k[:, :, 1], v_a, lam, rel_bias)
    o = rms_norm(o, subln_g) * (1.0 - lambda_init)
    y_a = (o.reshape(B, S, A_WIDTH) * jax.nn.silu(gate_a)) @ w_pa
    y_b = (spatial_gate(u_b, v_b, ln_g, ln_b, w_s, b_s) * jax.nn.silu(gate_b)) @ w_pb
    merged = jax.nn.sigmoid(m_a) * y_a + jax.nn.sigmoid(m_b) * y_b
    out = merged @ w_o
    return x + rms_norm(out, g_post)


def setup_inputs(seed: int = 0) -> dict:
    key = jax.random.key(seed)
    ks = jax.random.split(key, 20)
    f32 = jnp.float32
    nrm = lambda k, shape, s: jax.random.normal(k, shape, f32) * s
    return {
        "x_prompt": nrm(ks[0], (BATCH, SEQ, D_MODEL), 1.0),
        "x_sample": nrm(ks[1], (DEC_BATCH, DEC_SEQ, D_MODEL), 1.0),
        "g_pre": 1.0 + nrm(ks[2], (DEPTH, D_MODEL), 0.02),
        "w_in": nrm(ks[3], (DEPTH, D_MODEL, IN_COLS), D_MODEL ** -0.5),
        "lambda_q1": nrm(ks[4], (DEPTH, A_HEAD_DIM), 0.1),
        "lambda_k1": nrm(ks[5], (DEPTH, A_HEAD_DIM), 0.1),
        "lambda_q2": nrm(ks[6], (DEPTH, A_HEAD_DIM), 0.1),
        "lambda_k2": nrm(ks[7], (DEPTH, A_HEAD_DIM), 0.1),
        "subln_g": 1.0 + nrm(ks[8], (DEPTH, A_V_DIM), 0.02),
        "w_pa": nrm(ks[9], (DEPTH, A_WIDTH, D_MODEL), A_WIDTH ** -0.5),
        "ln_g": 1.0 + nrm(ks[10], (DEPTH, B_WIDTH), 0.02),
        "ln_b": nrm(ks[11], (DEPTH, B_WIDTH), 0.02),
        "w_s": nrm(ks[12], (DEPTH, B_GROUPS, CHUNK, CHUNK), CHUNK ** -0.5),
        "b_s": 1.0 + nrm(ks[13], (DEPTH, B_GROUPS, CHUNK), 0.1),
        "w_pb": nrm(ks[14], (DEPTH, B_WIDTH, D_MODEL), B_WIDTH ** -0.5),
        "w_o": nrm(ks[15], (DEPTH, D_MODEL, D_MODEL), D_MODEL ** -0.5),
        "g_post": 1.0 + nrm(ks[16], (DEPTH, D_MODEL), 0.02),
        "rel_bias": nrm(ks[17], (REL_BUCKETS, A_HEADS), 0.2),
    }


def reference(x_prompt, x_sample, g_pre, w_in, lambda_q1, lambda_k1, lambda_q2, lambda_k2, subln_g,
              w_pa, ln_g, ln_b, w_s, b_s, w_pb, w_o, g_post, rel_bias):
    y_prompt = x_prompt
    y_sample = x_sample
    for l in range(DEPTH):
        args = (g_pre[l], w_in[l], lambda_q1[l], lambda_k1[l], lambda_q2[l], lambda_k2[l], subln_g[l],
                w_pa[l], ln_g[l], ln_b[l], w_s[l], b_s[l], w_pb[l], w_o[l], g_post[l], rel_bias)
        y_prompt = encoder_layer(y_prompt, l, *args)
        y_sample = encoder_layer(y_sample, l, *args)
    return (y_prompt, y_sample)
```

```cpp
#ifndef MK_MULTI
#define MK_MULTI 0
#endif
#include <hip/hip_runtime.h>
#include <hip/hip_cooperative_groups.h>
#include <cstdio>
#include <cstdint>
namespace cg = cooperative_groups;
namespace pg8 {
#define PG8_LAS __attribute__((address_space(3)))
typedef unsigned short bf16_t;
typedef short bf16x8 __attribute__((ext_vector_type(8)));
typedef float f32x4 __attribute__((ext_vector_type(4)));
typedef unsigned u32x4 __attribute__((ext_vector_type(4)));
constexpr int BM = 256, BK = 64, HALF = 128, HTB = HALF * BK * 2  , STAGE_BYTES = 8 * HTB, NXCD = 8, WGM = 8;

__host__ __device__ __forceinline__ int lds_byte(int r, int c) { const int st = (r >> 4) * 2 + (c >> 5), rr = r & 15, cc = c & 31, ob = rr * 64 + cc * 2; return st * 1024 + (ob ^ (((ob >> 9) & 1) << 5)); }
__host__ __device__ __forceinline__ void stage_rc(int b, int& R, int& C) { const int st = b / 1024, sb = b % 1024, swz = sb ^ (((sb >> 9) & 1) << 5); R = (st >> 1) * 16 + swz / 64; C = (st & 1) * 32 + (swz % 64) / 2; }
__host__ __device__ __forceinline__ int perm32(int rho) { const int n = rho >> 4, i = rho & 15; return 8 * (i >> 2) + 4 * n + (i & 3); }

struct Unit { int pm, pn, half; };
struct Gemm { const bf16_t* A; const bf16_t* Bt; int M, N, K, lda, ldb; const bf16_t* A2; const bf16_t* Bt2; };

struct StaticOrder {
    int nM, nN, nwg, G, c;
    __host__ __device__ void init(int M, int N, int G_, int c_) { nM = M / BM; nN = N / BM; nwg = nM * nN; G = G_; c = c_; }
    __host__ __device__ bool next(int i, Unit& u) const {
        const long L = (long)i * G + c; if (L >= nwg) return false;
        int wgid = (int)L; { const int q = nwg / NXCD, r = nwg % NXCD, xcd = wgid % NXCD, off = wgid / NXCD; wgid = (xcd < r ? xcd * (q + 1) : r * (q + 1) + (xcd - r) * q) + off; }
        const int nig = WGM * nN, gid = wgid / nig, fm = gid * WGM, gsz = (nM - fm) < WGM ? (nM - fm) : WGM;
        u.pm = fm + ((wgid % nig) % gsz); u.pn = (wgid % nig) / gsz; u.half = 0; return true;
    }
    __device__ __forceinline__ void a_ready(const Unit&) const {}
    __device__ __forceinline__ void done(const Unit&) const {}
};


struct DualOrder { StaticOrder so;
    __host__ __device__ void init(int M, int N, int G_, int c_) { so.init(M, N, G_, c_); }
    __host__ __device__ bool next(int i, Unit& u) const { if (!so.next(i >> 1, u)) return false; u.half = i & 1; return true; }
    __device__ __forceinline__ void a_ready(const Unit&) const {}
    __device__ __forceinline__ void done(const Unit&) const {}
};
typedef float f32x2 __attribute__((ext_vector_type(2)));
typedef __bf16 bf16x2_t __attribute__((ext_vector_type(2)));
typedef unsigned u32x2 __attribute__((ext_vector_type(2)));
__device__ __forceinline__ unsigned cvt_pk_bf16(float lo, float hi) { f32x2 v = {lo, hi}; bf16x2_t b = __builtin_convertvector(v, bf16x2_t); return __builtin_bit_cast(unsigned, b); }
__device__ __forceinline__ float bf_lo(unsigned w) { return __uint_as_float(w << 16); }
__device__ __forceinline__ float bf_hi(unsigned w) { return __uint_as_float(w & 0xffff0000u); }
__device__ __forceinline__ float sigmoidf_fast(float x) { return __builtin_amdgcn_rcpf(1.0f + __builtin_amdgcn_exp2f(-1.4426950408889634f * x)); }

struct EpiInProj {
    static constexpr bool PERM = true, AFTER_DRAIN = false, DUAL = false;
    bf16_t* Z; int ldc; const float* rs; int qcols; float qscale; unsigned char* KV; int sshift;
    __device__ __forceinline__ void operator()(const f32x4 (&acc)[2][2][4][2], const Unit& u, int wr, int wc, int fr, int fq) const {
        const int row0 = u.pm * BM + wr * 64 + fr; const int colt = u.pn * BM; const int col0 = colt + wc * 32 + 8 * fq;
        const float cs = (colt < qcols) ? qscale : 1.0f;
        const bool kvt = (KV != nullptr) && colt >= 1024 && colt < 3072;
#pragma unroll
        for (int ai = 0; ai < 2; ++ai)
#pragma unroll
            for (int m = 0; m < 4; ++m) { const int r = row0 + ai * HALF + m * 16; const float s = rs ? rs[r] * cs : cs; bf16_t* rowp = Z + (size_t)r * ldc + col0;
                const int seq = r >> sshift, pos = r & ((1 << sshift) - 1), tile = pos >> 6, kv = pos & 63;
#pragma unroll
                for (int bj = 0; bj < 2; ++bj) { const f32x4 v0 = acc[ai][bj][m][0] * s, v1 = acc[ai][bj][m][1] * s; u32x4 w;
                    w.x = cvt_pk_bf16(v0[0], v0[1]); w.y = cvt_pk_bf16(v0[2], v0[3]); w.z = cvt_pk_bf16(v1[0], v1[1]); w.w = cvt_pk_bf16(v1[2], v1[3]);
                    if (kvt) { const int c = col0 + bj * HALF; int hd, off;
                        if (colt < 2048) { const int cp = c - 1024, d = cp & 63; hd = (cp >> 6) & 7; off = (cp >> 9) * 8192 + kv * 128 + (((d >> 3) ^ ((kv >> 1) & 7)) << 4); }
                        else { const int cp = c - 2048, d = cp & 127; hd = cp >> 7; off = 16384 + (d >> 5) * 4096 + kv * 64 + (((d >> 3) & 3) << 4); }
                        *(u32x4*)(KV + ((size_t)((((seq << 3) + hd) << (sshift - 6)) + tile) << 15) + off) = w; }
                    else *(u32x4*)(rowp + bj * HALF) = w; } }
    }
};
struct EpiDual {
    static constexpr bool PERM = true, AFTER_DRAIN = false, DUAL = true;
    const bf16_t* Ga; const bf16_t* Gb; int ldg; bf16_t* O; int ldo;
    __device__ __forceinline__ void operator()(f32x4 (&acc)[2][2][4][2], const Unit& u, int wr, int wc, int fr, int fq) const {
        const int row0 = u.pm * BM + wr * 64 + fr; const int col0 = u.pn * BM + wc * 32 + 8 * fq;
#pragma unroll
        for (int ai = 0; ai < 2; ++ai)
#pragma unroll
            for (int m = 0; m < 4; ++m) { const int r = row0 + ai * HALF + m * 16;
#pragma unroll
                for (int bj = 0; bj < 2; ++bj) { const int c = col0 + bj * HALF;
                    const u32x4 gb = *(const u32x4*)(Gb + (size_t)r * ldg + c);
                    float eb[8];
#pragma unroll
                    for (int e = 0; e < 4; ++e) { eb[2 * e] = __builtin_amdgcn_exp2f(-1.4426950408889634f * bf_lo(gb[e])); eb[2 * e + 1] = __builtin_amdgcn_exp2f(-1.4426950408889634f * bf_hi(gb[e])); }
                    if (u.half == 0) { const u32x4 ga = *(const u32x4*)(Ga + (size_t)r * ldg + c);
#pragma unroll
                        for (int e = 0; e < 4; ++e) { const float ea0 = __builtin_amdgcn_exp2f(-1.4426950408889634f * bf_lo(ga[e])), ea1 = __builtin_amdgcn_exp2f(-1.4426950408889634f * bf_hi(ga[e]));
                            acc[ai][bj][m][e >> 1][(2 * e) & 3] *= (1.0f + eb[2 * e]) * __builtin_amdgcn_rcpf(1.0f + ea0);
                            acc[ai][bj][m][e >> 1][(2 * e + 1) & 3] *= (1.0f + eb[2 * e + 1]) * __builtin_amdgcn_rcpf(1.0f + ea1); } }
                    else { u32x4 w;
#pragma unroll
                        for (int e = 0; e < 4; ++e) { const float a0 = acc[ai][bj][m][e >> 1][(2 * e) & 3] * __builtin_amdgcn_rcpf(1.0f + eb[2 * e]), a1 = acc[ai][bj][m][e >> 1][(2 * e + 1) & 3] * __builtin_amdgcn_rcpf(1.0f + eb[2 * e + 1]);
                            w[e] = cvt_pk_bf16(a0, a1); }
                        *(u32x4*)(O + (size_t)r * ldo + c) = w; } } }
    }
};

template <class Epi, class Sched, bool ALIGN_EPI = false, bool SP2 = false>
__device__ __forceinline__ void gemm_phase(PG8_LAS unsigned char* lds, const Gemm g, const Sched& S, const Epi& E) {
    int tid_ = threadIdx.x; asm volatile("" : "+v"(tid_));
    const int tid = tid_, wid = __builtin_amdgcn_readfirstlane(tid >> 6), lane = tid & 63, wr = wid >> 2, wc = wid & 3, fr = lane & 15, fq = lane >> 4;
    const int K = g.K, nt = K / BK;
    unsigned voffA[2], voffB[2];
#pragma unroll
    for (int i = 0; i < 2; ++i) { int R, C; stage_rc(tid * 16 + i * 8192, R, C); const int Rb = Epi::PERM ? ((R & ~31) + perm32(R & 31)) : R;
        voffA[i] = (unsigned)(R * g.lda + C) * 2u; voffB[i] = (unsigned)(Rb * g.ldb + C) * 2u; }
    const unsigned kstep = (unsigned)(BK * 2);
    const unsigned hstepA = (unsigned)HALF * g.lda * 2, hstepB = (unsigned)HALF * g.ldb * 2;
    const unsigned tstepA = 2 * hstepA, tstepB = 2 * hstepB;
    const __amdgpu_buffer_rsrc_t rsA = __builtin_amdgcn_make_buffer_rsrc((void*)g.A, (short)0, 0x7fffffff, 0x00020000), rsB = __builtin_amdgcn_make_buffer_rsrc((void*)g.Bt, (short)0, 0x7fffffff, 0x00020000);
    const unsigned dA2 = Epi::DUAL ? (unsigned)((const char*)g.A2 - (const char*)g.A) : 0u, dB2 = Epi::DUAL ? (unsigned)((const char*)g.Bt2 - (const char*)g.Bt) : 0u;
    const unsigned ldsw = (unsigned)wid * 1024u;
    const int aoff = lds_byte(wr * 64 + fr, fq * 8), boff = lds_byte(wc * 32 + fr, fq * 8);
#define PG8_SA(b, h) (((b) * 2 + (h)) * HTB)
#define PG8_SB(b, h) ((4 + (b) * 2 + (h)) * HTB)
#define PG8_STAGE(RS, bufoff, soff, voff) do { _Pragma("unroll") for (int _i = 0; _i < 2; ++_i) \
        __builtin_amdgcn_raw_ptr_buffer_load_lds(RS, (PG8_LAS void*)(lds + (bufoff) + ldsw + _i * 8192), 16, (voff)[_i], (soff), 0, 0); } while (0)
#define PG8_LDA(dst, b, h) do { _Pragma("unroll") for (int m = 0; m < 4; ++m) _Pragma("unroll") for (int k = 0; k < 2; ++k) dst[m][k] = *(const PG8_LAS bf16x8*)(lds + PG8_SA(b, h) + aoff + m * 2048 + k * 1024); } while (0)
#define PG8_LDB(dst, b, h) do { _Pragma("unroll") for (int n = 0; n < 2; ++n) _Pragma("unroll") for (int k = 0; k < 2; ++k) dst[n][k] = *(const PG8_LAS bf16x8*)(lds + PG8_SB(b, h) + boff + n * 2048 + k * 1024); } while (0)
#define PG8_MMA(ai, bj, At, Bt) do { __builtin_amdgcn_s_setprio(1); _Pragma("unroll") for (int m = 0; m < 4; ++m) _Pragma("unroll") for (int n = 0; n < 2; ++n) _Pragma("unroll") for (int k = 0; k < 2; ++k) \
        acc[ai][bj][m][n] = __builtin_amdgcn_mfma_f32_16x16x32_bf16(Bt[n][k], At[m][k], acc[ai][bj][m][n], 0, 0, 0); __builtin_amdgcn_s_setprio(0); } while (0)
#define PG8_WAIT_V(n) asm volatile("s_waitcnt vmcnt(" #n ")" ::: "memory")
#define PG8_WAIT_L(n) asm volatile("s_waitcnt lgkmcnt(" #n ")" ::: "memory")
#define PG8_BAR __builtin_amdgcn_s_barrier()
#define PG8_SCHED __builtin_amdgcn_sched_barrier(0)
    Unit cur, nxt; int ui = 0;
    if (!S.next(0, cur)) return;
    f32x4 acc[2][2][4][2];
#pragma unroll
    for (int a = 0; a < 2; ++a)
#pragma unroll
        for (int b = 0; b < 2; ++b)
#pragma unroll
            for (int m = 0; m < 4; ++m)
#pragma unroll
                for (int n = 0; n < 2; ++n) acc[a][b][m][n] = (f32x4){0.f, 0.f, 0.f, 0.f};
    bf16x8 At[4][2], B0[2][2], B1[2][2];
    unsigned cA = ((Epi::DUAL && cur.half) ? dA2 : 0u) + (unsigned)cur.pm * tstepA, cB = ((Epi::DUAL && cur.half) ? dB2 : 0u) + (unsigned)cur.pn * tstepB;
    S.a_ready(cur);
    if constexpr (SP2) {
        PG8_STAGE(rsB, PG8_SB(0, 0), cB, voffB); PG8_STAGE(rsB, PG8_SB(0, 1), cB + hstepB, voffB); PG8_STAGE(rsA, PG8_SA(0, 0), cA, voffA); PG8_STAGE(rsA, PG8_SA(0, 1), cA + hstepA, voffA);
        if (wr == 1) PG8_BAR;
        PG8_WAIT_V(2); PG8_BAR;
        PG8_STAGE(rsB, PG8_SB(1, 0), cB + kstep, voffB); PG8_STAGE(rsA, PG8_SA(1, 0), cA + kstep, voffA); PG8_STAGE(rsB, PG8_SB(1, 1), cB + hstepB + kstep, voffB);
        PG8_WAIT_V(6); PG8_BAR;
    } else {
        PG8_STAGE(rsB, PG8_SB(0, 0), cB, voffB); PG8_STAGE(rsA, PG8_SA(0, 0), cA, voffA); PG8_STAGE(rsB, PG8_SB(0, 1), cB + hstepB, voffB); PG8_STAGE(rsA, PG8_SA(0, 1), cA + hstepA, voffA);
        if (wr == 1) PG8_BAR;
        PG8_WAIT_V(4); PG8_BAR;
        PG8_STAGE(rsB, PG8_SB(1, 0), cB + kstep, voffB); PG8_STAGE(rsA, PG8_SA(1, 0), cA + kstep, voffA); PG8_STAGE(rsB, PG8_SB(1, 1), cB + hstepB + kstep, voffB);
        PG8_WAIT_V(6); PG8_BAR;
    }
    for (;;) {
        const bool has_next = S.next(ui + 1, nxt);
        const unsigned nA = has_next ? ((Epi::DUAL && nxt.half) ? dA2 : 0u) + (unsigned)nxt.pm * tstepA : cA, nB = has_next ? ((Epi::DUAL && nxt.half) ? dB2 : 0u) + (unsigned)nxt.pn * tstepB : cB;
        for (int t = 0; t < nt; t += 2) {
            const bool last = (t == nt - 2);
            const unsigned a1 = cA + (unsigned)(t + 1) * kstep;
            const unsigned a2 = last ? nA : cA + (unsigned)(t + 2) * kstep, b2 = last ? nB : cB + (unsigned)(t + 2) * kstep;
            const unsigned a3 = a2 + kstep, b3 = b2 + kstep;
            if (last && has_next) S.a_ready(nxt);
            if constexpr (SP2) {
            PG8_LDB(B0, 0, 0); PG8_LDB(B1, 0, 1); PG8_SCHED; PG8_LDA(At, 0, 0); PG8_STAGE(rsA, PG8_SA(1, 1), a1 + hstepA, voffA);
            PG8_WAIT_V(8); PG8_WAIT_L(0); PG8_BAR; PG8_MMA(0, 0, At, B0); PG8_MMA(0, 1, At, B1); PG8_BAR; PG8_SCHED;
            PG8_LDA(At, 0, 1); PG8_STAGE(rsB, PG8_SB(0, 0), b2, voffB); PG8_STAGE(rsB, PG8_SB(0, 1), b2 + hstepB, voffB); PG8_STAGE(rsA, PG8_SA(0, 0), a2, voffA);
            PG8_WAIT_V(8); PG8_WAIT_L(0); PG8_BAR; PG8_MMA(1, 0, At, B0); PG8_MMA(1, 1, At, B1); PG8_BAR; PG8_SCHED;
            PG8_LDB(B0, 1, 0); PG8_LDB(B1, 1, 1); PG8_SCHED; PG8_LDA(At, 1, 0); PG8_STAGE(rsA, PG8_SA(0, 1), a2 + hstepA, voffA);
            PG8_WAIT_V(8); PG8_WAIT_L(0); PG8_BAR; PG8_MMA(0, 0, At, B0); PG8_MMA(0, 1, At, B1); PG8_BAR; PG8_SCHED;
            PG8_LDA(At, 1, 1); PG8_STAGE(rsB, PG8_SB(1, 0), b3, voffB); PG8_STAGE(rsB, PG8_SB(1, 1), b3 + hstepB, voffB); PG8_STAGE(rsA, PG8_SA(1, 0), a3, voffA);
            PG8_WAIT_V(8); PG8_WAIT_L(0); PG8_BAR; PG8_MMA(1, 0, At, B0); PG8_MMA(1, 1, At, B1); PG8_BAR; PG8_SCHED;
            } else {
            PG8_LDB(B0, 0, 0); PG8_SCHED; PG8_LDA(At, 0, 0); PG8_STAGE(rsA, PG8_SA(1, 1), a1 + hstepA, voffA);
            PG8_WAIT_L(8); PG8_BAR; PG8_WAIT_L(0); PG8_MMA(0, 0, At, B0); PG8_BAR; PG8_SCHED;
            PG8_LDB(B1, 0, 1); PG8_STAGE(rsB, PG8_SB(0, 0), b2, voffB);
            PG8_BAR; PG8_WAIT_L(0); PG8_MMA(0, 1, At, B1); PG8_BAR;
            PG8_LDA(At, 0, 1); PG8_STAGE(rsA, PG8_SA(0, 0), a2, voffA);
            PG8_BAR; PG8_WAIT_L(0); PG8_MMA(1, 0, At, B0); PG8_BAR; PG8_SCHED;
            PG8_STAGE(rsB, PG8_SB(0, 1), b2 + hstepB, voffB);
            PG8_WAIT_V(6); PG8_BAR; PG8_MMA(1, 1, At, B1); PG8_BAR;
            PG8_LDB(B0, 1, 0); PG8_SCHED; PG8_LDA(At, 1, 0); PG8_STAGE(rsA, PG8_SA(0, 1), a2 + hstepA, voffA);
            PG8_WAIT_L(8); PG8_BAR; PG8_WAIT_L(0); PG8_MMA(0, 0, At, B0); PG8_BAR; PG8_SCHED;
            PG8_LDB(B1, 1, 1); PG8_STAGE(rsB, PG8_SB(1, 0), b3, voffB);
            PG8_BAR; PG8_WAIT_L(0); PG8_MMA(0, 1, At, B1); PG8_BAR;
            PG8_LDA(At, 1, 1); PG8_STAGE(rsA, PG8_SA(1, 0), a3, voffA);
            PG8_BAR; PG8_WAIT_L(0); PG8_MMA(1, 0, At, B0); PG8_BAR; PG8_SCHED;
            PG8_STAGE(rsB, PG8_SB(1, 1), b3 + hstepB, voffB);
            PG8_WAIT_V(6); PG8_BAR; PG8_MMA(1, 1, At, B1); PG8_BAR;
            }
        }
        if constexpr (ALIGN_EPI) { if (wr == 0) PG8_BAR; }
        if constexpr (!Epi::AFTER_DRAIN) { E(acc, cur, wr, wc, fr, fq); S.done(cur); }
        if (!has_next) break;
        if (!(Epi::DUAL && nxt.half))
#pragma unroll
        for (int a = 0; a < 2; ++a)
#pragma unroll
            for (int b = 0; b < 2; ++b)
#pragma unroll
                for (int m = 0; m < 4; ++m)
#pragma unroll
                    for (int n = 0; n < 2; ++n) acc[a][b][m][n] = (f32x4){0.f, 0.f, 0.f, 0.f};
        cur = nxt; cA = nA; cB = nB; ++ui;
        if constexpr (ALIGN_EPI) { if (wr == 1) PG8_BAR; }
    }
    PG8_WAIT_V(0);
    if constexpr (!ALIGN_EPI) { if (wr == 0) PG8_BAR; }
    PG8_BAR;
    if constexpr (Epi::AFTER_DRAIN) { E.fused(acc, cur, wr, wc, fr, fq, lds, wid, lane); S.done(cur); }
#undef PG8_SA
#undef PG8_SB
#undef PG8_STAGE
#undef PG8_LDA
#undef PG8_LDB
#undef PG8_MMA
#undef PG8_WAIT_V
#undef PG8_WAIT_L
#undef PG8_BAR
#undef PG8_SCHED
}
}

#define LAS __attribute__((address_space(3)))
typedef unsigned short bf16_t;
typedef short bf16x8 __attribute__((ext_vector_type(8)));
typedef short s16x4 __attribute__((ext_vector_type(4)));
typedef float f32x4 __attribute__((ext_vector_type(4)));
typedef float f32x16 __attribute__((ext_vector_type(16)));
typedef unsigned u32x4 __attribute__((ext_vector_type(4)));
typedef unsigned u32x2 __attribute__((ext_vector_type(2)));
using pg8::cvt_pk_bf16; using pg8::bf_lo; using pg8::bf_hi; using pg8::sigmoidf_fast;

constexpr int DM = 1024, ZLD = 9216, GT = 32768, NGROUP = 3, NTHREADS = 512, NWAVES = 8;
constexpr int COL_Q = 0, COL_K = 1024, COL_V = 2048, COL_GA = 3072, COL_U = 4096, COL_VB = 5120, COL_GB = 6144, COL_MA = 7168, COL_MB = 8192;
constexpr float LOG2E = 1.4426950408889634f, C2 = 0.125f * LOG2E, EPS = 1e-6f;
constexpr float LAMBDA_INIT = 0.2f;
constexpr size_t MiB = 1u << 20;
constexpr size_t WS_WIN = 0, WS_WPA = 18 * MiB, WS_WPB = 20 * MiB, WS_WO = 22 * MiB, WS_WSB = 24 * MiB, WS_RS = 25 * MiB, WS_XB = 26 * MiB, WS_Z = 90 * MiB, WS_BAR = 666 * MiB, WS_KV = 667 * MiB, WS_END = 795 * MiB;
constexpr int LDS_BYTES = 135168;

struct Params {
    const float *x_prompt, *x_sample, *g_pre, *w_in, *lq1, *lk1, *lq2, *lk2, *subln_g, *w_pa, *ln_g, *ln_b, *w_s, *b_s, *w_pb, *w_o, *g_post, *rel_bias;
    float* out; unsigned char* ws;
};

__device__ __forceinline__ int fresh_lane() { int t = threadIdx.x; asm volatile("" : "+v"(t)); return t & 63; }
__device__ __forceinline__ float shx(float v, int o, int lane) { return __int_as_float(__builtin_amdgcn_ds_bpermute((lane ^ o) << 2, __float_as_int(v))); }
__device__ __forceinline__ float wave_sum(float v, int lane) {
#pragma unroll
    for (int o = 1; o < 64; o <<= 1) v += shx(v, o, lane);
    return v;
}
__device__ __forceinline__ unsigned f2bf(float f) { unsigned u = __builtin_bit_cast(unsigned, f); return (u + 0x7fffu + ((u >> 16) & 1u)) >> 16; }
__device__ __forceinline__ unsigned pk2(float lo, float hi) { return f2bf(lo) | (f2bf(hi) << 16); }

__device__ __forceinline__ void transpose_item(const float* W, int K, int N, bf16_t* WT, const float* sk, LAS float* scr, int item, int lane) {
    const int nblk = N / 32, kb = item / nblk, nb = item % nblk, k0 = 64 * kb, n0 = 32 * nb;
#pragma unroll 8
    for (int i = 0; i < 32; ++i) { const int kk = 2 * i + (lane >> 5); float v = W[(size_t)(k0 + kk) * N + n0 + (lane & 31)]; if (sk) v *= sk[k0 + kk]; scr[kk * 33 + (lane & 31)] = v; }
    asm volatile("s_waitcnt lgkmcnt(0)" ::: "memory");
    const int c = lane & 7;
#pragma unroll
    for (int j = 0; j < 4; ++j) { const int n = (lane >> 3) + 8 * j; const LAS float* s = scr + (8 * c) * 33 + n;
        u32x4 o; o.x = pk2(s[0 * 33], s[1 * 33]); o.y = pk2(s[2 * 33], s[3 * 33]); o.z = pk2(s[4 * 33], s[5 * 33]); o.w = pk2(s[6 * 33], s[7 * 33]);
        *(u32x4*)(WT + (size_t)(n0 + n) * K + k0 + 8 * c) = o; }
    asm volatile("s_waitcnt lgkmcnt(0)" ::: "memory");
}

__device__ __forceinline__ void phase_a(const float* x, bf16_t* xb, float* rs, int gw, int ngw) {
    const int lane = fresh_lane();
    for (int m0 = gw * 4; m0 < GT; m0 += ngw * 4) {
        f32x4 v[4][4];
#pragma unroll
        for (int q = 0; q < 4; ++q) { const f32x4* xr = (const f32x4*)(x + (size_t)(m0 + q) * DM) + lane;
#pragma unroll
            for (int j = 0; j < 4; ++j) v[q][j] = __builtin_nontemporal_load(xr + 64 * j); }
#pragma unroll
        for (int q = 0; q < 4; ++q) { float s = 0.f;
#pragma unroll
            for (int j = 0; j < 4; ++j) s += (v[q][j].x * v[q][j].x + v[q][j].y * v[q][j].y) + (v[q][j].z * v[q][j].z + v[q][j].w * v[q][j].w);
            const float r = 1.0f / sqrtf(wave_sum(s, lane) * (1.0f / DM) + EPS);
            if (lane == 0) rs[m0 + q] = r;
            u32x2* o8 = (u32x2*)(xb + (size_t)(m0 + q) * DM) + lane;
#pragma unroll
            for (int j = 0; j < 4; ++j) { u32x2 w; w.x = cvt_pk_bf16(v[q][j].x, v[q][j].y); w.y = cvt_pk_bf16(v[q][j].z, v[q][j].w); o8[64 * j] = w; } }
    }
}
__device__ __forceinline__ void phase_f(const float* x, float* out, const bf16_t* ob, int ldo, const float* g_post, int gw, int ngw) {
    const int lane = fresh_lane();
    f32x4 gp[4];
#pragma unroll
    for (int j = 0; j < 4; ++j) gp[j] = ((const f32x4*)g_post)[lane + 64 * j];
    for (int m0 = gw * 4; m0 < GT; m0 += ngw * 4) {
        u32x2 v[4][4]; f32x4 xv[4][4];
#pragma unroll
        for (int q = 0; q < 4; ++q) { const u32x2* orow = (const u32x2*)(ob + (size_t)(m0 + q) * ldo) + lane; const f32x4* xr = (const f32x4*)(x + (size_t)(m0 + q) * DM) + lane;
#pragma unroll
            for (int j = 0; j < 4; ++j) { v[q][j] = orow[64 * j]; xv[q][j] = __builtin_nontemporal_load(xr + 64 * j); } }
#pragma unroll
        for (int q = 0; q < 4; ++q) { float s = 0.f; f32x4 f[4];
#pragma unroll
            for (int j = 0; j < 4; ++j) { f[j] = (f32x4){bf_lo(v[q][j].x), bf_hi(v[q][j].x), bf_lo(v[q][j].y), bf_hi(v[q][j].y)}; s += (f[j].x * f[j].x + f[j].y * f[j].y) + (f[j].z * f[j].z + f[j].w * f[j].w); }
            const float r = 1.0f / sqrtf(wave_sum(s, lane) * (1.0f / DM) + EPS);
            f32x4* orow = (f32x4*)(out + (size_t)(m0 + q) * DM) + lane;
#pragma unroll
            for (int j = 0; j < 4; ++j) __builtin_nontemporal_store(xv[q][j] + f[j] * r * gp[j], orow + 64 * j); }
    }
}

__device__ __forceinline__ int crow(int r, int hi) { return (r & 3) + 8 * (r >> 2) + 4 * hi; }

__device__ __forceinline__ void gate_unit(LAS unsigned char* lds, bf16_t* Zg, int ch, const bf16_t* wsb, const float* ln_g, const float* ln_b, const float* b_s, bool dostore = true) {
    int tid_ = threadIdx.x; asm volatile("" : "+v"(tid_));
    const int tid = tid_, lane = tid & 63, r32 = lane & 31, hi = lane >> 5; const int wid = __builtin_amdgcn_readfirstlane(tid >> 6);
    LAS float* stats = (LAS float*)lds;
    LAS bf16_t* vnT = (LAS bf16_t*)(lds + 2048);
    bf16_t* Zc = Zg + (size_t)ch * 128 * ZLD;
    {
        const int row = tid >> 2, part = tid & 3; const bf16_t* src = Zc + (size_t)row * ZLD + COL_VB + part * 8;
        float s = 0.f, s2 = 0.f;
#pragma unroll 8
        for (int i = 0; i < 32; ++i) { const u32x4 w = *(const u32x4*)(src + i * 32);
#pragma unroll
            for (int e = 0; e < 4; ++e) { const float a = bf_lo(w[e]), b = bf_hi(w[e]); s += a + b; s2 += a * a + b * b; } }
        s += shx(s, 1, lane); s += shx(s, 2, lane); s2 += shx(s2, 1, lane); s2 += shx(s2, 2, lane);
        const float mean = s * (1.0f / 1024.0f); const float var = fmaxf(s2 * (1.0f / 1024.0f) - mean * mean, 0.f);
        if (part == 0) { stats[row * 2] = mean; stats[row * 2 + 1] = 1.0f / sqrtf(var + EPS); }
    }
    __syncthreads();
    const int pt = wid >> 1, kt0 = 2 * (wid & 1);
    for (int g = 0; g < 8; ++g) {
#pragma unroll
        for (int i = 0; i < 4; ++i) { const int p = tid + 512 * i, q = p >> 4, c = p & 15; const int col = g * 128 + c * 8;
            const u32x4 w = *(const u32x4*)(Zc + (size_t)q * ZLD + COL_VB + col);
            const float mean = stats[q * 2], rstd = stats[q * 2 + 1];
            const f32x4 g0 = *(const f32x4*)(ln_g + col), g1 = *(const f32x4*)(ln_g + col + 4), b0 = *(const f32x4*)(ln_b + col), b1 = *(const f32x4*)(ln_b + col + 4);
            float v[8] = {bf_lo(w.x), bf_hi(w.x), bf_lo(w.y), bf_hi(w.y), bf_lo(w.z), bf_hi(w.z), bf_lo(w.w), bf_hi(w.w)};
            const float gg[8] = {g0.x, g0.y, g0.z, g0.w, g1.x, g1.y, g1.z, g1.w}, bb[8] = {b0.x, b0.y, b0.z, b0.w, b1.x, b1.y, b1.z, b1.w};
            const int qs = ((((q >> 3) ^ c) << 3) | (q & 7));
#pragma unroll
            for (int e = 0; e < 8; ++e) vnT[(c * 8 + e) * 136 + qs] = (bf16_t)f2bf((v[e] - mean) * rstd * gg[e] + bb[e]); }
        __syncthreads();
        f32x16 acc[2]; acc[0] = f32x16{}; acc[1] = f32x16{};
        const bf16_t* ap = wsb + (size_t)g * 16384 + (32 * pt + r32) * 128 + 8 * hi;
#pragma unroll
        for (int ks = 0; ks < 8; ++ks) { const bf16x8 a = *(const bf16x8*)(ap + 16 * ks);
#pragma unroll
            for (int j = 0; j < 2; ++j) { const int kk = 32 * (kt0 + j) + r32; const bf16x8 b = *(const LAS bf16x8*)(vnT + kk * 136 + ((((2 * ks + hi) ^ ((kk >> 3) & 15))) << 3));
                acc[j] = __builtin_amdgcn_mfma_f32_32x32x16_bf16(a, b, acc[j], 0, 0, 0); } }
        LAS float* st = (LAS float*)(lds + 40960);
#pragma unroll
        for (int j = 0; j < 2; ++j)
#pragma unroll
            for (int r = 0; r < 16; ++r) { const int p = 32 * pt + crow(r, hi); st[p * 132 + 32 * (kt0 + j) + r32] = acc[j][r] + b_s[g * 128 + p]; }
        __syncthreads();
#pragma unroll
        for (int i = 0; i < 4; ++i) { const int p = (tid >> 4) + 32 * i, c8 = (tid & 15) * 8; bf16_t* zr = Zc + (size_t)p * ZLD + g * 128 + c8;
            const u32x4 uw = *(const u32x4*)(zr + COL_U), gw = *(const u32x4*)(zr + COL_GB);
            const f32x4 s0 = *(const LAS f32x4*)(st + p * 132 + c8), s1 = *(const LAS f32x4*)(st + p * 132 + c8 + 4);
            const float sv[8] = {s0.x, s0.y, s0.z, s0.w, s1.x, s1.y, s1.z, s1.w}; u32x4 ow;
#pragma unroll
            for (int e = 0; e < 4; ++e) { const float u0 = bf_lo(uw[e]), u1 = bf_hi(uw[e]), g0 = bf_lo(gw[e]), g1 = bf_hi(gw[e]);
                ow[e] = cvt_pk_bf16(u0 * sv[2 * e] * g0 * sigmoidf_fast(g0), u1 * sv[2 * e + 1] * g1 * sigmoidf_fast(g1)); }
            if (dostore) *(u32x4*)(zr + COL_U) = ow; }
        __syncthreads();
    }
}

__device__ __forceinline__ s16x4 vtr(const LAS unsigned char* p) { typedef short v4i16_t __attribute__((ext_vector_type(4))); return __builtin_bit_cast(s16x4, __builtin_amdgcn_ds_read_tr16_b64_v4i16((LAS v4i16_t*)p)); }

__device__ __forceinline__ void attn_unit(LAS unsigned char* lds, bf16_t* Zg, const unsigned char* KVg, int S, int b, int h, int qb, const float* lq1, const float* lk1, const float* lq2, const float* lk2, const float* subln_g, const float* rel_bias, bool dostore = true) {
    int tid_ = threadIdx.x; asm volatile("" : "+v"(tid_));
    const int tid = tid_, lane = tid & 63, r32 = lane & 31, hi = lane >> 5; const int wid = __builtin_amdgcn_readfirstlane(tid >> 6);
    const int qsub = wid & 3, mp = wid >> 2;
    const size_t rowbase = (size_t)b * S; const int q0 = qb * 128, qw0 = q0 + 32 * qsub;
    LAS float* tab = (LAS float*)(lds + 131072);
    LAS float* wsf = (LAS float*)(lds + 131072 + 2304) + wid * 32;
    const int NT = S / 64; const size_t tstep = (size_t)64 * ZLD;
    const unsigned char* kvb = KVg + ((size_t)((b * 8 + h) * NT) << 15);
    const __amdgpu_buffer_rsrc_t kvr = __builtin_amdgcn_make_buffer_rsrc((void*)kvb, (short)0, NT << 15, 0x00020000);
    const unsigned kvo = wid * 1024 + lane * 16;
    const unsigned vvo = 16384 + (wid >> 1) * 4096 + (wid & 1) * 2048 + lane * 16;
    const unsigned kdma = wid * 1024, vdma = 65536 + (wid >> 1) * 4096 + (wid & 1) * 2048;
#define DMAB(voff, soff, imm, dstoff) __builtin_amdgcn_raw_ptr_buffer_load_lds(kvr, (LAS void*)(lds + (dstoff)), 16, (voff), (soff), (imm), 0)
#define ISSUE_K(tile, slot) do { const int s_ = (tile) << 15; DMAB(kvo, s_, 0, (slot) * 16384 + kdma); DMAB(kvo, s_ + 8192, 0, (slot) * 16384 + 8192 + kdma); } while (0)
#define ISSUE_V(tile, slot) do { const int s_ = (tile) << 15; DMAB(vvo, s_, 0, (slot) * 16384 + vdma); DMAB(vvo, s_ + 1024, 0, (slot) * 16384 + vdma + 1024); } while (0)
#define STEP_CLOSE() do { asm volatile("s_waitcnt vmcnt(0)" ::: "memory"); asm volatile("s_waitcnt lgkmcnt(0)" ::: "memory"); __builtin_amdgcn_s_barrier(); asm volatile("" ::: "memory"); } while (0)
    ISSUE_K(0, 0); ISSUE_V(0, 0); ISSUE_K(1, 1); ISSUE_K(2, 2); ISSUE_V(1, 1);
    for (int ti = tid; ti < 513; ti += 512) { const int rel = ti - 256, n = rel < 0 ? -rel : rel;
        int bk = n < 8 ? n : n < 12 ? 8 : n < 16 ? 9 : n < 23 ? 10 : n < 32 ? 11 : n < 46 ? 12 : n < 64 ? 13 : n < 91 ? 14 : 15; if (rel > 0) bk += 16;
        tab[ti] = rel_bias[bk * 8 + h] * LOG2E; }
    bf16x8 qr[4];
    { const bf16_t* qp = Zg + (rowbase + qw0 + r32) * ZLD + COL_Q + mp * 512 + h * 64 + hi * 8;
#pragma unroll
      for (int d0 = 0; d0 < 4; ++d0) qr[d0] = *(const bf16x8*)(qp + d0 * 16); }
    asm volatile("s_waitcnt vmcnt(0)" ::: "memory");
    __syncthreads();
    const float c_neg = tab[0], c_pos = tab[512];
    float mhat = 0.f, lsum = 0.f; f32x16 o[4]; o[0] = f32x16{}; o[1] = f32x16{}; o[2] = f32x16{}; o[3] = f32x16{};
    const unsigned vlane = 65536 + (4 * hi + ((lane & 15) >> 2)) * 64 + ((lane >> 4) & 1) * 32 + (lane & 3) * 8;
    unsigned kla[4];
#pragma unroll
    for (int d0 = 0; d0 < 4; ++d0) kla[d0] = mp * 8192 + r32 * 128 + (((2 * d0 + hi) ^ ((r32 >> 1) & 7)) << 4);
    f32x16 cinit;
    f32x16 pA0, pA1, pB0, pB1; u32x4 pw0, pw1, pw2, pw3;
#define SB() __builtin_amdgcn_sched_barrier(0)
#define PEL(P0, P1, idx) ((idx) < 16 ? P0[(idx) & 15] : P1[(idx) & 15])
#define EXPEL(C0, C1, idx) do { if ((idx) < 16) C0[(idx) & 15] = __builtin_amdgcn_exp2f(C0[(idx) & 15]); else C1[(idx) & 15] = __builtin_amdgcn_exp2f(C1[(idx) & 15]); } while (0)
#define VOFF(i) (((i) & 3) * 4096 + ((i) >> 2) * 1024)
#define VTR(dst, off) asm volatile("ds_read_b64_tr_b16 %0, %1 offset:%c2" : "=&v"(dst) : "v"(vbase), "i"(off) : "memory")
#define TILE_CB(k0v) ((((k0v) + 63 - qw0) <= -91) ? c_neg : ((((k0v) - (qw0 + 31)) >= 91) ? c_pos : 0.f))
#define NEAR_BIAS(C0, C1, k0v) do { if (!((((k0v) + 63 - qw0) <= -91) || (((k0v) - (qw0 + 31)) >= 91))) { const LAS float* tp_ = tab + ((k0v) + 4 * hi - (qw0 + r32) + 256);     \
        _Pragma("unroll") for (int r = 0; r < 16; ++r) { C0[r] += tp_[(r & 3) + 8 * (r >> 2)]; C1[r] += tp_[(r & 3) + 8 * (r >> 2) + 32]; } } } while (0)
#define SET_CINIT(k0v) do { const float ci_ = TILE_CB(k0v) - mhat; _Pragma("unroll") for (int r = 0; r < 16; ++r) cinit[r] = ci_; } while (0)
#define RESCALE_O() do { asm volatile("s_waitcnt lgkmcnt(0)" ::: "memory"); \
        _Pragma("unroll") for (int g = 0; g < 4; ++g) { const f32x4 a4 = *(const LAS f32x4*)(wsf + 8 * g + 4 * hi); \
            _Pragma("unroll") for (int db = 0; db < 4; ++db) { o[db][4 * g] *= a4.x; o[db][4 * g + 1] *= a4.y; o[db][4 * g + 2] *= a4.z; o[db][4 * g + 3] *= a4.w; } } } while (0)
    {
        bf16x8 kf_[8]; const LAS unsigned char* kb_ = lds;
#pragma unroll
        for (int i_ = 0; i_ < 4; ++i_) { kf_[2 * i_] = *(const LAS bf16x8*)(kb_ + kla[i_]); kf_[2 * i_ + 1] = *(const LAS bf16x8*)(kb_ + kla[i_] + 4096); }
        SET_CINIT(0);
#pragma unroll
        for (int i_ = 0; i_ < 8; ++i_) { if (i_ & 1) pA1 = __builtin_amdgcn_mfma_f32_32x32x16_bf16(kf_[i_], qr[i_ >> 1], (i_ < 2) ? cinit : pA1, 0, 0, 0);
                                         else        pA0 = __builtin_amdgcn_mfma_f32_32x32x16_bf16(kf_[i_], qr[i_ >> 1], (i_ < 2) ? cinit : pA0, 0, 0, 0); }
        NEAR_BIAS(pA0, pA1, 0);
        float rm_ = fmaxf(pA0[0], pA1[0]);
#pragma unroll
        for (int r = 1; r < 16; ++r) rm_ = fmaxf(fmaxf(rm_, pA0[r]), pA1[r]);
        { auto rr_ = __builtin_amdgcn_permlane32_swap(__float_as_uint(rm_), __float_as_uint(rm_), false, false); rm_ = fmaxf(__uint_as_float(rr_[0]), __uint_as_float(rr_[1])); }
        mhat = rm_;
#pragma unroll
        for (int r = 0; r < 16; ++r) { pA0[r] = __builtin_amdgcn_exp2f(pA0[r] - rm_); pA1[r] = __builtin_amdgcn_exp2f(pA1[r] - rm_); }
        SET_CINIT(64);
        STEP_CLOSE();
    }
#define STEP(HS, ISS, CLS, C0, C1, P0, P1, T, SL) do { \
    const int t_ = (T); const int k0_ = t_ * 64; \
    const int dk_ = ((t_ + 2 < NT) ? t_ + 2 : NT - 1) << 15, dv_ = ((t_ + 1 < NT) ? t_ + 1 : NT - 1) << 15; const unsigned dks_ = (((SL) + 2) & 3) * 16384 + kdma, dvs_ = (((SL) + 1) & 3) * 16384 + vdma;     \
    bf16x8 kf_[8]; \
    const LAS unsigned char* kb_ = lds + (SL) * 16384; \
    if (HS) { \
        _Pragma("unroll") for (int i_ = 0; i_ < 2; ++i_) { kf_[2 * i_] = *(const LAS bf16x8*)(kb_ + kla[i_]); kf_[2 * i_ + 1] = *(const LAS bf16x8*)(kb_ + kla[i_] + 4096); } } \
    SB(); \
    float sacc_ = 0.f; \
    _Pragma("unroll") for (int i_ = 0; i_ < 8; ++i_) { \
        if (HS) { if (i_ < 4) kf_[4 + i_] = *(const LAS bf16x8*)(kb_ + kla[(4 + i_) >> 1] + ((4 + i_) & 1) * 4096); \
                  if (ISS && (CLS)) { if (i_ == 1) DMAB(kvo, dk_, 0, dks_); else if (i_ == 3) DMAB(kvo, dk_ + 8192, 0, dks_ + 8192); else if (i_ == 5) DMAB(vvo, dv_, 0, dvs_); else if (i_ == 7) DMAB(vvo, dv_ + 1024, 0, dvs_ + 1024); } \
                  if (i_ & 1) C1 = __builtin_amdgcn_mfma_f32_32x32x16_bf16(kf_[i_], qr[i_ >> 1], (i_ < 2) ? cinit : C1, 0, 0, 0); \
                  else        C0 = __builtin_amdgcn_mfma_f32_32x32x16_bf16(kf_[i_], qr[i_ >> 1], (i_ < 2) ? cinit : C0, 0, 0, 0); } \
        { const float e0_ = PEL(P0, P1, 4 * i_), e1_ = PEL(P0, P1, 4 * i_ + 1), e2_ = PEL(P0, P1, 4 * i_ + 2), e3_ = PEL(P0, P1, 4 * i_ + 3); \
            sacc_ += (e0_ + e1_) + (e2_ + e3_); const unsigned w0_ = cvt_pk_bf16(e0_, e1_), w1_ = cvt_pk_bf16(e2_, e3_); \
            if ((i_ >> 1) == 0) { pw0[(i_ & 1) * 2] = w0_; pw0[(i_ & 1) * 2 + 1] = w1_; } else if ((i_ >> 1) == 1) { pw1[(i_ & 1) * 2] = w0_; pw1[(i_ & 1) * 2 + 1] = w1_; } \
            else if ((i_ >> 1) == 2) { pw2[(i_ & 1) * 2] = w0_; pw2[(i_ & 1) * 2 + 1] = w1_; } else { pw3[(i_ & 1) * 2] = w0_; pw3[(i_ & 1) * 2 + 1] = w1_; } \
            asm volatile("" : "+v"(sacc_)); if ((i_ >> 1) == 0) asm volatile("" : "+v"(pw0)); else if ((i_ >> 1) == 1) asm volatile("" : "+v"(pw1)); else if ((i_ >> 1) == 2) asm volatile("" : "+v"(pw2)); else asm volatile("" : "+v"(pw3)); } \
        SB(); } \
    lsum += sacc_; \
    if (HS) NEAR_BIAS(C0, C1, k0_); \
    SB(); \
    float mrun_ = -1e30f; \
    s16x4 vl_[16], vh_[16]; const unsigned vbase = (unsigned)(uintptr_t)(lds + (((SL) + 3) & 3) * 16384 + vlane); \
    _Pragma("unroll") for (int i_ = 0; i_ < 3; ++i_) { VTR(vl_[i_], VOFF(i_)); VTR(vh_[i_], VOFF(i_) + 512); } \
    _Pragma("unroll") for (int i_ = 0; i_ < 16; ++i_) { \
        { if (i_ + 3 < 16) { VTR(vl_[i_ + 3], VOFF(i_ + 3)); VTR(vh_[i_ + 3], VOFF(i_ + 3) + 512); } \
            if (i_ <= 12) asm volatile("s_waitcnt lgkmcnt(6)" ::: "memory"); else if (i_ == 13) asm volatile("s_waitcnt lgkmcnt(4)" ::: "memory"); else if (i_ == 14) asm volatile("s_waitcnt lgkmcnt(2)" ::: "memory"); else asm volatile("s_waitcnt lgkmcnt(0)" ::: "memory"); \
            asm volatile("" : "+v"(vl_[i_]), "+v"(vh_[i_])); \
            const bf16x8 vf_ = {vl_[i_][0], vl_[i_][1], vl_[i_][2], vl_[i_][3], vh_[i_][0], vh_[i_][1], vh_[i_][2], vh_[i_][3]}; \
            const bf16x8 pa_ = __builtin_bit_cast(bf16x8, (i_ >> 2) == 0 ? pw0 : (i_ >> 2) == 1 ? pw1 : (i_ >> 2) == 2 ? pw2 : pw3); \
            o[i_ & 3] = __builtin_amdgcn_mfma_f32_32x32x16_bf16(pa_, vf_, o[i_ & 3], 0, 0, 0); } \
        if (HS) { if (ISS && !(CLS)) { if (i_ == 2) DMAB(kvo, dk_, 0, dks_); else if (i_ == 5) DMAB(kvo, dk_ + 8192, 0, dks_ + 8192); else if (i_ == 8) DMAB(vvo, dv_, 0, dvs_); else if (i_ == 11) DMAB(vvo, dv_ + 1024, 0, dvs_ + 1024); }     \
                  mrun_ = fmaxf(fmaxf(mrun_, PEL(C0, C1, 2 * i_)), PEL(C0, C1, 2 * i_ + 1)); EXPEL(C0, C1, 2 * i_); EXPEL(C0, C1, 2 * i_ + 1); \
            asm volatile("" : "+v"(mrun_)); if (i_ < 8) asm volatile("" : "+v"(C0)); else asm volatile("" : "+v"(C1)); } \
        SB(); } \
    if (HS) { \
        { auto rr_ = __builtin_amdgcn_permlane32_swap(__float_as_uint(mrun_), __float_as_uint(mrun_), false, false); mrun_ = fmaxf(__uint_as_float(rr_[0]), __uint_as_float(rr_[1])); } \
        const bool resc_ = __any(mrun_ > 8.0f); \
        if (resc_) { const float dl_ = fmaxf(mrun_, 0.f); mhat += dl_; const float alpha_ = __builtin_amdgcn_exp2f(-dl_); lsum *= alpha_; if (hi == 0) wsf[r32] = alpha_; \
            _Pragma("unroll") for (int r = 0; r < 16; ++r) { C0[r] *= alpha_; C1[r] *= alpha_; } \
            RESCALE_O(); } \
        if (resc_ || (TILE_CB(k0_ + 64) != TILE_CB(k0_))) SET_CINIT(k0_ + 64); \
    } \
    if (CLS) STEP_CLOSE(); \
} while (0)
    if (wid >= 4) __builtin_amdgcn_s_setprio(1);
    int t = 1;
    for (; t + 4 < NT; t += 4) {
        STEP(true, true, false, pB0, pB1, pA0, pA1, t, 1);
        STEP(true, true, true, pA0, pA1, pB0, pB1, t + 1, 2);
        STEP(true, true, false, pB0, pB1, pA0, pA1, t + 2, 3);
        STEP(true, true, true, pA0, pA1, pB0, pB1, t + 3, 0);
    }
    STEP(true, true, false, pB0, pB1, pA0, pA1, NT - 3, 1);
    STEP(true, true, true, pA0, pA1, pB0, pB1, NT - 2, 2);
    STEP(true, false, false, pB0, pB1, pA0, pA1, NT - 1, 3);
    STEP(false, false, false, pA0, pA1, pB0, pB1, NT, 0);
    __builtin_amdgcn_s_setprio(0);
    asm volatile("s_waitcnt vmcnt(0)" ::: "memory");
    __syncthreads();
#undef STEP_CLOSE
#undef ISSUE_V
#undef ISSUE_K
#undef DMAB
#undef STEP
#undef RESCALE_O
#undef SET_CINIT
#undef NEAR_BIAS
#undef TILE_CB
#undef VTR
#undef VOFF
#undef EXPEL
#undef PEL
#undef SB
    { auto rr_ = __builtin_amdgcn_permlane32_swap(__float_as_uint(lsum), __float_as_uint(lsum), false, false); lsum = __uint_as_float(rr_[0]) + __uint_as_float(rr_[1]); }
    const float lam = __builtin_amdgcn_exp2f(LOG2E * wave_sum(lq1[lane] * lk1[lane], lane)) - __builtin_amdgcn_exp2f(LOG2E * wave_sum(lq2[lane] * lk2[lane], lane)) + LAMBDA_INIT;
    if (hi == 0) wsf[r32] = (mp == 1 ? lam : 1.0f) / lsum;
    asm volatile("s_waitcnt lgkmcnt(0)" ::: "memory");
    float inv[16];
#pragma unroll
    for (int g = 0; g < 4; ++g) { const f32x4 a4 = *(const LAS f32x4*)(wsf + 8 * g + 4 * hi); inv[4 * g] = a4.x; inv[4 * g + 1] = a4.y; inv[4 * g + 2] = a4.z; inv[4 * g + 3] = a4.w; }
    LAS float* exch = (LAS float*)lds;
    if (mp == 1) {
#pragma unroll
        for (int db = 0; db < 4; ++db)
#pragma unroll
            for (int r = 0; r < 16; ++r) exch[(32 * qsub + crow(r, hi)) * 128 + db * 32 + r32] = o[db][r] * inv[r];
    }
    __syncthreads();
    if (mp == 0) {
        float ss[16];
#pragma unroll
        for (int r = 0; r < 16; ++r) { float a = 0.f;
#pragma unroll
            for (int db = 0; db < 4; ++db) { const float d = o[db][r] * inv[r] - exch[(32 * qsub + crow(r, hi)) * 128 + db * 32 + r32]; o[db][r] = d; a += d * d; }
            ss[r] = a; }
#pragma unroll
        for (int r = 0; r < 16; ++r) {
#pragma unroll
            for (int sft = 1; sft < 32; sft <<= 1) ss[r] += shx(ss[r], sft, lane);
            ss[r] = (1.0f - LAMBDA_INIT) / sqrtf(ss[r] * (1.0f / 128.0f) + EPS); }
#pragma unroll
        for (int db = 0; db < 4; ++db) { const float sg = subln_g[db * 32 + r32];
#pragma unroll
            for (int r = 0; r < 16; ++r) exch[(32 * qsub + crow(r, hi)) * 128 + db * 32 + r32] = o[db][r] * ss[r] * sg; }
    }
    __syncthreads();
#pragma unroll
    for (int i = 0; i < 4; ++i) { const int p = (tid >> 4) + 32 * i, c8 = (tid & 15) * 8; bf16_t* zp = Zg + (rowbase + q0 + p) * ZLD + COL_GA + h * 128 + c8;
        const u32x4 gw = *(const u32x4*)zp; const f32x4 s0 = *(const LAS f32x4*)(exch + p * 128 + c8), s1 = *(const LAS f32x4*)(exch + p * 128 + c8 + 4);
        const float sv[8] = {s0.x, s0.y, s0.z, s0.w, s1.x, s1.y, s1.z, s1.w}; u32x4 ow;
#pragma unroll
        for (int e = 0; e < 4; ++e) { const float g0 = bf_lo(gw[e]), g1 = bf_hi(gw[e]); ow[e] = cvt_pk_bf16(sv[2 * e] * g0 * sigmoidf_fast(g0), sv[2 * e + 1] * g1 * sigmoidf_fast(g1)); }
        if (dostore) *(u32x4*)zp = ow; }
    __syncthreads();
}


__device__ __forceinline__ void grid_barrier(unsigned* ctr, unsigned target) {
    asm volatile("s_waitcnt vmcnt(0)" ::: "memory");
    __syncthreads();
    if (threadIdx.x == 0) {
        __builtin_amdgcn_fence(__ATOMIC_RELEASE, "agent");
        asm volatile("s_waitcnt vmcnt(0)" ::: "memory");
        __hip_atomic_fetch_add(ctr, 1u, __ATOMIC_RELAXED, __HIP_MEMORY_SCOPE_AGENT);
        unsigned spins = 0;
        while (__hip_atomic_load(ctr, __ATOMIC_RELAXED, __HIP_MEMORY_SCOPE_AGENT) < target) { __builtin_amdgcn_s_sleep(1); if (++spins > (1u << 26)) break; }
        __builtin_amdgcn_fence(__ATOMIC_ACQUIRE, "agent");
        asm volatile("s_waitcnt vmcnt(0)" ::: "memory");
    }
    __syncthreads();
}
__global__ void __launch_bounds__(NTHREADS, 2) fwd_megakernel(Params P, int ph_lo, int ph_hi, int use_sync) {
    extern __shared__ __attribute__((aligned(16))) unsigned char lds_raw[];
    LAS unsigned char* lds = (LAS unsigned char*)lds_raw;
    cg::grid_group grid = cg::this_grid();
    const int wave = __builtin_amdgcn_readfirstlane((int)threadIdx.x >> 6);
    const int G = gridDim.x, bx = blockIdx.x; const int vcu = (G % 8 == 0) ? (bx % 8) * (G / 8) + bx / 8 : bx;
    const int gw = vcu * NWAVES + wave, ngw = G * NWAVES;
    unsigned char* ws = P.ws;
    bf16_t* Win = (bf16_t*)(ws + WS_WIN); bf16_t* Wpa = (bf16_t*)(ws + WS_WPA); bf16_t* Wpb = (bf16_t*)(ws + WS_WPB); bf16_t* Wo = (bf16_t*)(ws + WS_WO);
    bf16_t* Wsb = (bf16_t*)(ws + WS_WSB); float* RS = (float*)(ws + WS_RS); bf16_t* XB = (bf16_t*)(ws + WS_XB); bf16_t* Z = (bf16_t*)(ws + WS_Z); unsigned* BAR = (unsigned*)(ws + WS_BAR);
    int ph = 0;
#define RUN(k) ((k) >= ph_lo && (k) < ph_hi)
#define SEAM() do { if (use_sync && ph >= ph_lo && ph + 1 < ph_hi) { if (ph == 0) grid.sync(); else grid_barrier(BAR, (unsigned)ph * (unsigned)G); } ++ph; } while (0)
    if (RUN(ph)) {
        LAS float* scr = (LAS float*)(lds + wave * 16384);
        const int lane = fresh_lane(); const int tid = wave * 64 + lane;
        constexpr int I_IN = (DM / 64) * (ZLD / 32), I_SQ = (DM / 64) * (DM / 32), NITEMS = I_IN + 3 * I_SQ;
        for (int it = gw; it < NITEMS; it += ngw) { int r = it;
            if (r < I_IN) { transpose_item(P.w_in, DM, ZLD, Win, P.g_pre, scr, r, lane); continue; } r -= I_IN;
            if (r < I_SQ) { transpose_item(P.w_pa, DM, DM, Wpa, nullptr, scr, r, lane); continue; } r -= I_SQ;
            if (r < I_SQ) { transpose_item(P.w_pb, DM, DM, Wpb, nullptr, scr, r, lane); continue; } r -= I_SQ;
            transpose_item(P.w_o, DM, DM, Wo, nullptr, scr, r, lane); }
        for (int i = (bx * NTHREADS + tid) * 4; i < 8 * 128 * 128; i += G * NTHREADS * 4) { const f32x4 v = *(const f32x4*)(P.w_s + i); u32x2 w; w.x = cvt_pk_bf16(v.x, v.y); w.y = cvt_pk_bf16(v.z, v.w); *(u32x2*)(Wsb + i) = w; }
        phase_a(P.x_prompt, XB, RS, gw, ngw);
    }
    SEAM();
    for (int g = 0; g < NGROUP; ++g) {
        const float* xg = (g == 0) ? P.x_prompt : P.x_sample + (size_t)(g - 1) * GT * DM;
        float* outg = P.out + (size_t)g * GT * DM;
        const int S = (g == 0) ? 16384 : 4096, NB = GT / S;
        if (RUN(ph)) {
            pg8::Gemm gm{XB, Win, GT, ZLD, DM, DM, DM, nullptr, nullptr}; pg8::StaticOrder So; So.init(GT, ZLD, G, bx);
            pg8::EpiInProj E{Z, ZLD, RS, 1024, C2, ws + WS_KV, (g == 0) ? 14 : 12};
            pg8::gemm_phase<pg8::EpiInProj, pg8::StaticOrder, true, true>(lds, gm, So, E);
        }
        SEAM();
        if (RUN(ph)) {
            for (int ch = vcu; ch < GT / 128; ch += G) gate_unit(lds, Z, ch, Wsb, P.ln_g, P.ln_b, P.b_s);
            const int nqb = S / 128, nunits = NB * 8 * nqb;
            for (int u = vcu; u < nunits; u += G) { const int bh = u / nqb, qb = u % nqb; attn_unit(lds, Z, ws + WS_KV, S, bh >> 3, bh & 7, qb, P.lq1, P.lk1, P.lq2, P.lk2, P.subln_g, P.rel_bias); }
        }
        SEAM();
        if (RUN(ph)) {
            pg8::DualOrder So; So.init(GT, DM, G, bx);
            pg8::Gemm gm{Z + COL_GA, Wpa, GT, DM, DM, ZLD, DM, Z + COL_U, Wpb}; pg8::EpiDual E{Z + COL_MA, Z + COL_MB, ZLD, XB, DM};
            pg8::gemm_phase<pg8::EpiDual, pg8::DualOrder, true, true>(lds, gm, So, E);
        }
        SEAM();
        if (RUN(ph)) {
            pg8::Gemm gm{XB, Wo, GT, DM, DM, DM, DM, nullptr, nullptr}; pg8::StaticOrder So; So.init(GT, DM, G, bx);
            pg8::EpiInProj E{Z + COL_Q, ZLD, nullptr, 0, 1.0f, nullptr, 12};
            pg8::gemm_phase<pg8::EpiInProj, pg8::StaticOrder, true, true>(lds, gm, So, E);
        }
        SEAM();
        if (RUN(ph)) {
            phase_f(xg, outg, Z + COL_Q, ZLD, P.g_post, gw, ngw);
            if (g + 1 < NGROUP) phase_a(P.x_sample + (size_t)g * GT * DM, XB, RS, gw, ngw);
        }
        SEAM();
    }
#undef RUN
#undef SEAM
}
constexpr int N_PHASES = 1 + NGROUP * 5;

extern "C" void kernel_launch(void* const* d_in, const int* in_sizes, int n_in, void* d_out, int out_size, void* d_ws, size_t ws_size, hipStream_t stream) {
    static int grid = 0;
    if (grid == 0) {
        if (n_in != 18 || ws_size < WS_END) { fprintf(stderr, "kernel_launch: unexpected n_in %d / ws_size %zu\n", n_in, ws_size); grid = -1; return; }
        int dev = 0, cus = 0, per_cu = 0;
        hipGetDevice(&dev); hipDeviceGetAttribute(&cus, hipDeviceAttributeMultiprocessorCount, dev);
        if (hipFuncSetAttribute((const void*)fwd_megakernel, hipFuncAttributeMaxDynamicSharedMemorySize, LDS_BYTES) != hipSuccess) { fprintf(stderr, "kernel_launch: hipFuncSetAttribute failed\n"); grid = -1; return; }
        if (hipOccupancyMaxActiveBlocksPerMultiprocessor(&per_cu, (const void*)fwd_megakernel, NTHREADS, LDS_BYTES) != hipSuccess || per_cu < 1) { fprintf(stderr, "kernel_launch: occupancy query says %d\n", per_cu); per_cu = 1; }
        (void)hipGetLastError();
        grid = cus * 1;
    }
    if (grid < 0) return;
    Params p{};
    p.x_prompt = (const float*)d_in[0]; p.x_sample = (const float*)d_in[1]; p.g_pre = (const float*)d_in[2]; p.w_in = (const float*)d_in[3];
    p.lq1 = (const float*)d_in[4]; p.lk1 = (const float*)d_in[5]; p.lq2 = (const float*)d_in[6]; p.lk2 = (const float*)d_in[7]; p.subln_g = (const float*)d_in[8];
    p.w_pa = (const float*)d_in[9]; p.ln_g = (const float*)d_in[10]; p.ln_b = (const float*)d_in[11]; p.w_s = (const float*)d_in[12]; p.b_s = (const float*)d_in[13];
    p.w_pb = (const float*)d_in[14]; p.w_o = (const float*)d_in[15]; p.g_post = (const float*)d_in[16]; p.rel_bias = (const float*)d_in[17];
    p.out = (float*)d_out; p.ws = (unsigned char*)d_ws;
#if MK_MULTI
    for (int k = 0; k < N_PHASES; ++k) { int lo = k, hi = k + 1, us = 0; hipLaunchKernelGGL(fwd_megakernel, dim3(grid), dim3(NTHREADS), LDS_BYTES, stream, p, lo, hi, us); }
#else
    (void)hipMemsetAsync((unsigned char*)d_ws + WS_BAR, 0, 256, stream);
    int lo = 0, hi = N_PHASES, us = 1;
    void* args[] = {&p, &lo, &hi, &us};
    hipError_t e = hipLaunchCooperativeKernel((const void*)fwd_megakernel, dim3(grid), dim3(NTHREADS), args, LDS_BYTES, stream);
    if (e != hipSuccess) fprintf(stderr, "cooperative launch failed: %s (grid %d)\n", hipGetErrorString(e), grid);
#endif
}
```

```cpp
#ifndef MK_MULTI
#define MK_MULTI 0
#endif
#include <hip/hip_runtime.h>
#include <hip/hip_cooperative_groups.h>
#include <cstdio>
#include <cstdint>
namespace cg = cooperative_groups;
namespace pg8 {
#define PG8_LAS __attribute__((address_space(3)))
typedef unsigned short bf16_t;
typedef short bf16x8 __attribute__((ext_vector_type(8)));
typedef float f32x4 __attribute__((ext_vector_type(4)));
typedef unsigned u32x4 __attribute__((ext_vector_type(4)));
constexpr int BM = 256, BK = 64, HALF = 128, HTB = HALF * BK * 2  , STAGE_BYTES = 8 * HTB, NXCD = 8, WGM = 8;

__host__ __device__ __forceinline__ int lds_byte(int r, int c) { const int st = (r >> 4) * 2 + (c >> 5), rr = r & 15, cc = c & 31, ob = rr * 64 + cc * 2; return st * 1024 + (ob ^ (((ob >> 9) & 1) << 5)); }
__host__ __device__ __forceinline__ void stage_rc(int b, int& R, int& C) { const int st = b / 1024, sb = b % 1024, swz = sb ^ (((sb >> 9) & 1) << 5); R = (st >> 1) * 16 + swz / 64; C = (st & 1) * 32 + (swz % 64) / 2; }
__host__ __device__ __forceinline__ int perm32(int rho) { const int n = rho >> 4, i = rho & 15; return 8 * (i >> 2) + 4 * n + (i & 3); }

struct Unit { int pm, pn, half; };
struct Gemm { const bf16_t* A; const bf16_t* Bt; int M, N, K, lda, ldb; const bf16_t* A2; const bf16_t* Bt2; };

struct StaticOrder {
    int nM, nN, nwg, G, c;
    __host__ __device__ void init(int M, int N, int G_, int c_) { nM = M / BM; nN = N / BM; nwg = nM * nN; G = G_; c = c_; }
    __host__ __device__ bool next(int i, Unit& u) const {
        const long L = (long)i * G + c; if (L >= nwg) return false;
        int wgid = (int)L; { const int q = nwg / NXCD, r = nwg % NXCD, xcd = wgid % NXCD, off = wgid / NXCD; wgid = (xcd < r ? xcd * (q + 1) : r * (q + 1) + (xcd - r) * q) + off; }
        const int nig = WGM * nN, gid = wgid / nig, fm = gid * WGM, gsz = (nM - fm) < WGM ? (nM - fm) : WGM;
        u.pm = fm + ((wgid % nig) % gsz); u.pn = (wgid % nig) / gsz; u.half = 0; return true;
    }
    __device__ __forceinline__ void a_ready(const Unit&) const {}
    __device__ __forceinline__ void done(const Unit&) const {}
};


struct DualOrder { StaticOrder so;
    __host__ __device__ void init(int M, int N, int G_, int c_) { so.init(M, N, G_, c_); }
    __host__ __device__ bool next(int i, Unit& u) const { if (!so.next(i >> 1, u)) return false; u.half = i & 1; return true; }
    __device__ __forceinline__ void a_ready(const Unit&) const {}
    __device__ __forceinline__ void done(const Unit&) const {}
};
typedef float f32x2 __attribute__((ext_vector_type(2)));
typedef __bf16 bf16x2_t __attribute__((ext_vector_type(2)));
typedef unsigned u32x2 __attribute__((ext_vector_type(2)));
__device__ __forceinline__ unsigned cvt_pk_bf16(float lo, float hi) { f32x2 v = {lo, hi}; bf16x2_t b = __builtin_convertvector(v, bf16x2_t); return __builtin_bit_cast(unsigned, b); }
__device__ __forceinline__ float bf_lo(unsigned w) { return __uint_as_float(w << 16); }
__device__ __forceinline__ float bf_hi(unsigned w) { return __uint_as_float(w & 0xffff0000u); }
__device__ __forceinline__ float sigmoidf_fast(float x) { return __builtin_amdgcn_rcpf(1.0f + __builtin_amdgcn_exp2f(-1.4426950408889634f * x)); }

struct EpiInProj {
    static constexpr bool PERM = true, AFTER_DRAIN = false, DUAL = false;
    bf16_t* Z; int ldc; const float* rs; int qcols; float qscale; unsigned char* KV; int sshift;
    __device__ __forceinline__ void operator()(const f32x4 (&acc)[2][2][4][2], const Unit& u, int wr, int wc, int fr, int fq) const {
        const int row0 = u.pm * BM + wr * 64 + fr; const int colt = u.pn * BM; const int col0 = colt + wc * 32 + 8 * fq;
        const float cs = (colt < qcols) ? qscale : 1.0f;
        const bool kvt = (KV != nullptr) && colt >= 1024 && colt < 3072;
#pragma unroll
        for (int ai = 0; ai < 2; ++ai)
#pragma unroll
            for (int m = 0; m < 4; ++m) { const int r = row0 + ai * HALF + m * 16; const float s = rs ? rs[r] * cs : cs; bf16_t* rowp = Z + (size_t)r * ldc + col0;
                const int seq = r >> sshift, pos = r & ((1 << sshift) - 1), tile = pos >> 6, kv = pos & 63;
#pragma unroll
                for (int bj = 0; bj < 2; ++bj) { const f32x4 v0 = acc[ai][bj][m][0] * s, v1 = acc[ai][bj][m][1] * s; u32x4 w;
                    w.x = cvt_pk_bf16(v0[0], v0[1]); w.y = cvt_pk_bf16(v0[2], v0[3]); w.z = cvt_pk_bf16(v1[0], v1[1]); w.w = cvt_pk_bf16(v1[2], v1[3]);
                    if (kvt) { const int c = col0 + bj * HALF; int hd, off;
                        if (colt < 2048) { const int cp = c - 1024, d = cp & 63; hd = (cp >> 6) & 7; off = (cp >> 9) * 8192 + kv * 128 + (((d >> 3) ^ ((kv >> 1) & 7)) << 4); }
                        else { const int cp = c - 2048, d = cp & 127; hd = cp >> 7; off = 16384 + (d >> 5) * 4096 + kv * 64 + (((d >> 3) & 3) << 4); }
                        *(u32x4*)(KV + ((size_t)((((seq << 3) + hd) << (sshift - 6)) + tile) << 15) + off) = w; }
                    else *(u32x4*)(rowp + bj * HALF) = w; } }
    }
};
struct EpiDual {
    static constexpr bool PERM = true, AFTER_DRAIN = false, DUAL = true;
    const bf16_t* Ga; const bf16_t* Gb; int ldg; bf16_t* O; int ldo;
    __device__ __forceinline__ void operator()(f32x4 (&acc)[2][2][4][2], const Unit& u, int wr, int wc, int fr, int fq) const {
        const int row0 = u.pm * BM + wr * 64 + fr; const int col0 = u.pn * BM + wc * 32 + 8 * fq;
#pragma unroll
        for (int ai = 0; ai < 2; ++ai)
#pragma unroll
            for (int m = 0; m < 4; ++m) { const int r = row0 + ai * HALF + m * 16;
#pragma unroll
                for (int bj = 0; bj < 2; ++bj) { const int c = col0 + bj * HALF;
                    const u32x4 gb = *(const u32x4*)(Gb + (size_t)r * ldg + c);
                    float eb[8];
#pragma unroll
                    for (int e = 0; e < 4; ++e) { eb[2 * e] = __builtin_amdgcn_exp2f(-1.4426950408889634f * bf_lo(gb[e])); eb[2 * e + 1] = __builtin_amdgcn_exp2f(-1.4426950408889634f * bf_hi(gb[e])); }
                    if (u.half == 0) { const u32x4 ga = *(const u32x4*)(Ga + (size_t)r * ldg + c);
#pragma unroll
                        for (int e = 0; e < 4; ++e) { const float ea0 = __builtin_amdgcn_exp2f(-1.4426950408889634f * bf_lo(ga[e])), ea1 = __builtin_amdgcn_exp2f(-1.4426950408889634f * bf_hi(ga[e]));
                            acc[ai][bj][m][e >> 1][(2 * e) & 3] *= (1.0f + eb[2 * e]) * __builtin_amdgcn_rcpf(1.0f + ea0);
                            acc[ai][bj][m][e >> 1][(2 * e + 1) & 3] *= (1.0f + eb[2 * e + 1]) * __builtin_amdgcn_rcpf(1.0f + ea1); } }
                    else { u32x4 w;
#pragma unroll
                        for (int e = 0; e < 4; ++e) { const float a0 = acc[ai][bj][m][e >> 1][(2 * e) & 3] * __builtin_amdgcn_rcpf(1.0f + eb[2 * e]), a1 = acc[ai][bj][m][e >> 1][(2 * e + 1) & 3] * __builtin_amdgcn_rcpf(1.0f + eb[2 * e + 1]);
                            w[e] = cvt_pk_bf16(a0, a1); }
                        *(u32x4*)(O + (size_t)r * ldo + c) = w; } } }
    }
};

template <class Epi, class Sched, bool ALIGN_EPI = false, bool SP2 = false>
__device__ __forceinline__ void gemm_phase(PG8_LAS unsigned char* lds, const Gemm g, const Sched& S, const Epi& E) {
    int tid_ = threadIdx.x; asm volatile("" : "+v"(tid_));
    const int tid = tid_, wid = __builtin_amdgcn_readfirstlane(tid >> 6), lane = tid & 63, wr = wid >> 2, wc = wid & 3, fr = lane & 15, fq = lane >> 4;
    const int K = g.K, nt = K / BK;
    unsigned voffA[2], voffB[2];
#pragma unroll
    for (int i = 0; i < 2; ++i) { int R, C; stage_rc(tid * 16 + i * 8192, R, C); const int Rb = Epi::PERM ? ((R & ~31) + perm32(R & 31)) : R;
        voffA[i] = (unsigned)(R * g.lda + C) * 2u; voffB[i] = (unsigned)(Rb * g.ldb + C) * 2u; }
    const unsigned kstep = (unsigned)(BK * 2);
    const unsigned hstepA = (unsigned)HALF * g.lda * 2, hstepB = (unsigned)HALF * g.ldb * 2;
    const unsigned tstepA = 2 * hstepA, tstepB = 2 * hstepB;
    const __amdgpu_buffer_rsrc_t rsA = __builtin_amdgcn_make_buffer_rsrc((void*)g.A, (short)0, 0x7fffffff, 0x00020000), rsB = __builtin_amdgcn_make_buffer_rsrc((void*)g.Bt, (short)0, 0x7fffffff, 0x00020000);
    const unsigned dA2 = Epi::DUAL ? (unsigned)((const char*)g.A2 - (const char*)g.A) : 0u, dB2 = Epi::DUAL ? (unsigned)((const char*)g.Bt2 - (const char*)g.Bt) : 0u;
    const unsigned ldsw = (unsigned)wid * 1024u;
    const int aoff = lds_byte(wr * 64 + fr, fq * 8), boff = lds_byte(wc * 32 + fr, fq * 8);
#define PG8_SA(b, h) (((b) * 2 + (h)) * HTB)
#define PG8_SB(b, h) ((4 + (b) * 2 + (h)) * HTB)
#define PG8_STAGE(RS, bufoff, soff, voff) do { _Pragma("unroll") for (int _i = 0; _i < 2; ++_i) \
        __builtin_amdgcn_raw_ptr_buffer_load_lds(RS, (PG8_LAS void*)(lds + (bufoff) + ldsw + _i * 8192), 16, (voff)[_i], (soff), 0, 0); } while (0)
#define PG8_LDA(dst, b, h) do { _Pragma("unroll") for (int m = 0; m < 4; ++m) _Pragma("unroll") for (int k = 0; k < 2; ++k) dst[m][k] = *(const PG8_LAS bf16x8*)(lds + PG8_SA(b, h) + aoff + m * 2048 + k * 1024); } while (0)
#define PG8_LDB(dst, b, h) do { _Pragma("unroll") for (int n = 0; n < 2; ++n) _Pragma("unroll") for (int k = 0; k < 2; ++k) dst[n][k] = *(const PG8_LAS bf16x8*)(lds + PG8_SB(b, h) + boff + n * 2048 + k * 1024); } while (0)
#define PG8_MMA(ai, bj, At, Bt) do { __builtin_amdgcn_s_setprio(1); _Pragma("unroll") for (int m = 0; m < 4; ++m) _Pragma("unroll") for (int n = 0; n < 2; ++n) _Pragma("unroll") for (int k = 0; k < 2; ++k) \
        acc[ai][bj][m][n] = __builtin_amdgcn_mfma_f32_16x16x32_bf16(Bt[n][k], At[m][k], acc[ai][bj][m][n], 0, 0, 0); __builtin_amdgcn_s_setprio(0); } while (0)
#define PG8_WAIT_V(n) asm volatile("s_waitcnt vmcnt(" #n ")" ::: "memory")
#define PG8_WAIT_L(n) asm volatile("s_waitcnt lgkmcnt(" #n ")" ::: "memory")
#define PG8_BAR __builtin_amdgcn_s_barrier()
#define PG8_SCHED __builtin_amdgcn_sched_barrier(0)
    Unit cur, nxt; int ui = 0;
    if (!S.next(0, cur)) return;
    f32x4 acc[2][2][4][2];
#pragma unroll
    for (int a = 0; a < 2; ++a)
#pragma unroll
        for (int b = 0; b < 2; ++b)
#pragma unroll
            for (int m = 0; m < 4; ++m)
#pragma unroll
                for (int n = 0; n < 2; ++n) acc[a][b][m][n] = (f32x4){0.f, 0.f, 0.f, 0.f};
    bf16x8 At[4][2], B0[2][2], B1[2][2];
    unsigned cA = ((Epi::DUAL && cur.half) ? dA2 : 0u) + (unsigned)cur.pm * tstepA, cB = ((Epi::DUAL && cur.half) ? dB2 : 0u) + (unsigned)cur.pn * tstepB;
    S.a_ready(cur);
    if constexpr (SP2) {
        PG8_STAGE(rsB, PG8_SB(0, 0), cB, voffB); PG8_STAGE(rsB, PG8_SB(0, 1), cB + hstepB, voffB); PG8_STAGE(rsA, PG8_SA(0, 0), cA, voffA); PG8_STAGE(rsA, PG8_SA(0, 1), cA + hstepA, voffA);
        if (wr == 1) PG8_BAR;
        PG8_WAIT_V(2); PG8_BAR;
        PG8_STAGE(rsB, PG8_SB(1, 0), cB + kstep, voffB); PG8_STAGE(rsA, PG8_SA(1, 0), cA + kstep, voffA); PG8_STAGE(rsB, PG8_SB(1, 1), cB + hstepB + kstep, voffB);
        PG8_WAIT_V(6); PG8_BAR;
    } else {
        PG8_STAGE(rsB, PG8_SB(0, 0), cB, voffB); PG8_STAGE(rsA, PG8_SA(0, 0), cA, voffA); PG8_STAGE(rsB, PG8_SB(0, 1), cB + hstepB, voffB); PG8_STAGE(rsA, PG8_SA(0, 1), cA + hstepA, voffA);
        if (wr == 1) PG8_BAR;
        PG8_WAIT_V(4); PG8_BAR;
        PG8_STAGE(rsB, PG8_SB(1, 0), cB + kstep, voffB); PG8_STAGE(rsA, PG8_SA(1, 0), cA + kstep, voffA); PG8_STAGE(rsB, PG8_SB(1, 1), cB + hstepB + kstep, voffB);
        PG8_WAIT_V(6); PG8_BAR;
    }
    for (;;) {
        const bool has_next = S.next(ui + 1, nxt);
        const unsigned nA = has_next ? ((Epi::DUAL && nxt.half) ? dA2 : 0u) + (unsigned)nxt.pm * tstepA : cA, nB = has_next ? ((Epi::DUAL && nxt.half) ? dB2 : 0u) + (unsigned)nxt.pn * tstepB : cB;
        for (int t = 0; t < nt; t += 2) {
            const bool last = (t == nt - 2);
            const unsigned a1 = cA + (unsigned)(t + 1) * kstep;
            const unsigned a2 = last ? nA : cA + (unsigned)(t + 2) * kstep, b2 = last ? nB : cB + (unsigned)(t + 2) * kstep;
            const unsigned a3 = a2 + kstep, b3 = b2 + kstep;
            if (last && has_next) S.a_ready(nxt);
            if constexpr (SP2) {
            PG8_LDB(B0, 0, 0); PG8_LDB(B1, 0, 1); PG8_SCHED; PG8_LDA(At, 0, 0); PG8_STAGE(rsA, PG8_SA(1, 1), a1 + hstepA, voffA);
            PG8_WAIT_V(8); PG8_WAIT_L(0); PG8_BAR; PG8_MMA(0, 0, At, B0); PG8_MMA(0, 1, At, B1); PG8_BAR; PG8_SCHED;
            PG8_LDA(At, 0, 1); PG8_STAGE(rsB, PG8_SB(0, 0), b2, voffB); PG8_STAGE(rsB, PG8_SB(0, 1), b2 + hstepB, voffB); PG8_STAGE(rsA, PG8_SA(0, 0), a2, voffA);
            PG8_WAIT_V(8); PG8_WAIT_L(0); PG8_BAR; PG8_MMA(1, 0, At, B0); PG8_MMA(1, 1, At, B1); PG8_BAR; PG8_SCHED;
            PG8_LDB(B0, 1, 0); PG8_LDB(B1, 1, 1); PG8_SCHED; PG8_LDA(At, 1, 0); PG8_STAGE(rsA, PG8_SA(0, 1), a2 + hstepA, voffA);
            PG8_WAIT_V(8); PG8_WAIT_L(0); PG8_BAR; PG8_MMA(0, 0, At, B0); PG8_MMA(0, 1, At, B1); PG8_BAR; PG8_SCHED;
            PG8_LDA(At, 1, 1); PG8_STAGE(rsB, PG8_SB(1, 0), b3, voffB); PG8_STAGE(rsB, PG8_SB(1, 1), b3 + hstepB, voffB); PG8_STAGE(rsA, PG8_SA(1, 0), a3, voffA);
            PG8_WAIT_V(8); PG8_WAIT_L(0); PG8_BAR; PG8_MMA(1, 0, At, B0); PG8_MMA(1, 1, At, B1); PG8_BAR; PG8_SCHED;
            } else {
            PG8_LDB(B0, 0, 0); PG8_SCHED; PG8_LDA(At, 0, 0); PG8_STAGE(rsA, PG8_SA(1, 1), a1 + hstepA, voffA);
            PG8_WAIT_L(8); PG8_BAR; PG8_WAIT_L(0); PG8_MMA(0, 0, At, B0); PG8_BAR; PG8_SCHED;
            PG8_LDB(B1, 0, 1); PG8_STAGE(rsB, PG8_SB(0, 0), b2, voffB);
            PG8_BAR; PG8_WAIT_L(0); PG8_MMA(0, 1, At, B1); PG8_BAR;
            PG8_LDA(At, 0, 1); PG8_STAGE(rsA, PG8_SA(0, 0), a2, voffA);
            PG8_BAR; PG8_WAIT_L(0); PG8_MMA(1, 0, At, B0); PG8_BAR; PG8_SCHED;
            PG8_STAGE(rsB, PG8_SB(0, 1), b2 + hstepB, voffB);
            PG8_WAIT_V(6); PG8_BAR; PG8_MMA(1, 1, At, B1); PG8_BAR;
            PG8_LDB(B0, 1, 0); PG8_SCHED; PG8_LDA(At, 1, 0); PG8_STAGE(rsA, PG8_SA(0, 1), a2 + hstepA, voffA);
            PG8_WAIT_L(8); PG8_BAR; PG8_WAIT_L(0); PG8_MMA(0, 0, At, B0); PG8_BAR; PG8_SCHED;
            PG8_LDB(B1, 1, 1); PG8_STAGE(rsB, PG8_SB(1, 0), b3, voffB);
            PG8_BAR; PG8_WAIT_L(0); PG8_MMA(0, 1, At, B1); PG8_BAR;
            PG8_LDA(At, 1, 1); PG8_STAGE(rsA, PG8_SA(1, 0), a3, voffA);
            PG8_BAR; PG8_WAIT_L(0); PG8_MMA(1, 0, At, B0); PG8_BAR; PG8_SCHED;
            PG8_STAGE(rsB, PG8_SB(1, 1), b3 + hstepB, voffB);
            PG8_WAIT_V(6); PG8_BAR; PG8_MMA(1, 1, At, B1); PG8_BAR;
            }
        }
        if constexpr (ALIGN_EPI) { if (wr == 0) PG8_BAR; }
        if constexpr (!Epi::AFTER_DRAIN) { E(acc, cur, wr, wc, fr, fq); S.done(cur); }
        if (!has_next) break;
        if (!(Epi::DUAL && nxt.half))
#pragma unroll
        for (int a = 0; a < 2; ++a)
#pragma unroll
            for (int b = 0; b < 2; ++b)
#pragma unroll
                for (int m = 0; m < 4; ++m)
#pragma unroll
                    for (int n = 0; n < 2; ++n) acc[a][b][m][n] = (f32x4){0.f, 0.f, 0.f, 0.f};
        cur = nxt; cA = nA; cB = nB; ++ui;
        if constexpr (ALIGN_EPI) { if (wr == 1) PG8_BAR; }
    }
    PG8_WAIT_V(0);
    if constexpr (!ALIGN_EPI) { if (wr == 0) PG8_BAR; }
    PG8_BAR;
    if constexpr (Epi::AFTER_DRAIN) { E.fused(acc, cur, wr, wc, fr, fq, lds, wid, lane); S.done(cur); }
#undef PG8_SA
#undef PG8_SB
#undef PG8_STAGE
#undef PG8_LDA
#undef PG8_LDB
#undef PG8_MMA
#undef PG8_WAIT_V
#undef PG8_WAIT_L
#undef PG8_BAR
#undef PG8_SCHED
}
}

#define LAS __attribute__((address_space(3)))
typedef unsigned short bf16_t;
typedef short bf16x8 __attribute__((ext_vector_type(8)));
typedef short s16x4 __attribute__((ext_vector_type(4)));
typedef float f32x4 __attribute__((ext_vector_type(4)));
typedef float f32x16 __attribute__((ext_vector_type(16)));
typedef unsigned u32x4 __attribute__((ext_vector_type(4)));
typedef unsigned u32x2 __attribute__((ext_vector_type(2)));
using pg8::cvt_pk_bf16; using pg8::bf_lo; using pg8::bf_hi; using pg8::sigmoidf_fast;

constexpr int DM = 1024, ZLD = 9216, GT = 32768, NGROUP = 3, NTHREADS = 512, NWAVES = 8;
constexpr int COL_Q = 0, COL_K = 1024, COL_V = 2048, COL_GA = 3072, COL_U = 4096, COL_VB = 5120, COL_GB = 6144, COL_MA = 7168, COL_MB = 8192;
constexpr float LOG2E = 1.4426950408889634f, C2 = 0.125f * LOG2E, EPS = 1e-6f;
constexpr float LAMBDA_INIT = 0.2f;
constexpr size_t MiB = 1u << 20;
constexpr size_t WS_WIN = 0, WS_WPA = 18 * MiB, WS_WPB = 20 * MiB, WS_WO = 22 * MiB, WS_WSB = 24 * MiB, WS_RS = 25 * MiB, WS_XB = 26 * MiB, WS_Z = 90 * MiB, WS_BAR = 666 * MiB, WS_KV = 667 * MiB, WS_END = 795 * MiB;
constexpr int LDS_BYTES = 135168;

struct Params {
    const float *x_prompt, *x_sample, *g_pre, *w_in, *lq1, *lk1, *lq2, *lk2, *subln_g, *w_pa, *ln_g, *ln_b, *w_s, *b_s, *w_pb, *w_o, *g_post, *rel_bias;
    float* out; unsigned char* ws;
};

__device__ __forceinline__ int fresh_lane() { int t = threadIdx.x; asm volatile("" : "+v"(t)); return t & 63; }
__device__ __forceinline__ float shx(float v, int o, int lane) { return __int_as_float(__builtin_amdgcn_ds_bpermute((lane ^ o) << 2, __float_as_int(v))); }
__device__ __forceinline__ float wave_sum(float v, int lane) {
#pragma unroll
    for (int o = 1; o < 64; o <<= 1) v += shx(v, o, lane);
    return v;
}
__device__ __forceinline__ unsigned f2bf(float f) { unsigned u = __builtin_bit_cast(unsigned, f); return (u + 0x7fffu + ((u >> 16) & 1u)) >> 16; }
__device__ __forceinline__ unsigned pk2(float lo, float hi) { return f2bf(lo) | (f2bf(hi) << 16); }

__device__ __forceinline__ void transpose_item(const float* W, int K, int N, bf16_t* WT, const float* sk, LAS float* scr, int item, int lane) {
    const int nblk = N / 32, kb = item / nblk, nb = item % nblk, k0 = 64 * kb, n0 = 32 * nb;
#pragma unroll 8
    for (int i = 0; i < 32; ++i) { const int kk = 2 * i + (lane >> 5); float v = W[(size_t)(k0 + kk) * N + n0 + (lane & 31)]; if (sk) v *= sk[k0 + kk]; scr[kk * 33 + (lane & 31)] = v; }
    asm volatile("s_waitcnt lgkmcnt(0)" ::: "memory");
    const int c = lane & 7;
#pragma unroll
    for (int j = 0; j < 4; ++j) { const int n = (lane >> 3) + 8 * j; const LAS float* s = scr + (8 * c) * 33 + n;
        u32x4 o; o.x = pk2(s[0 * 33], s[1 * 33]); o.y = pk2(s[2 * 33], s[3 * 33]); o.z = pk2(s[4 * 33], s[5 * 33]); o.w = pk2(s[6 * 33], s[7 * 33]);
        *(u32x4*)(WT + (size_t)(n0 + n) * K + k0 + 8 * c) = o; }
    asm volatile("s_waitcnt lgkmcnt(0)" ::: "memory");
}

__device__ __forceinline__ void phase_a(const float* x, bf16_t* xb, float* rs, int gw, int ngw) {
    const int lane = fresh_lane();
    for (int m0 = gw * 4; m0 < GT; m0 += ngw * 4) {
        f32x4 v[4][4];
#pragma unroll
        for (int q = 0; q < 4; ++q) { const f32x4* xr = (const f32x4*)(x + (size_t)(m0 + q) * DM) + lane;
#pragma unroll
            for (int j = 0; j < 4; ++j) v[q][j] = __builtin_nontemporal_load(xr + 64 * j); }
#pragma unroll
        for (int q = 0; q < 4; ++q) { float s = 0.f;
#pragma unroll
            for (int j = 0; j < 4; ++j) s += (v[q][j].x * v[q][j].x + v[q][j].y * v[q][j].y) + (v[q][j].z * v[q][j].z + v[q][j].w * v[q][j].w);
            const float r = 1.0f / sqrtf(wave_sum(s, lane) * (1.0f / DM) + EPS);
            if (lane == 0) rs[m0 + q] = r;
            u32x2* o8 = (u32x2*)(xb + (size_t)(m0 + q) * DM) + lane;
#pragma unroll
            for (int j = 0; j < 4; ++j) { u32x2 w; w.x = cvt_pk_bf16(v[q][j].x, v[q][j].y); w.y = cvt_pk_bf16(v[q][j].z, v[q][j].w); o8[64 * j] = w; } }
    }
}
__device__ __forceinline__ void phase_f(const float* x, float* out, const bf16_t* ob, int ldo, const float* g_post, int gw, int ngw) {
    const int lane = fresh_lane();
    f32x4 gp[4];
#pragma unroll
    for (int j = 0; j < 4; ++j) gp[j] = ((const f32x4*)g_post)[lane + 64 * j];
    for (int m0 = gw * 4; m0 < GT; m0 += ngw * 4) {
        u32x2 v[4][4]; f32x4 xv[4][4];
#pragma unroll
        for (int q = 0; q < 4; ++q) { const u32x2* orow = (const u32x2*)(ob + (size_t)(m0 + q) * ldo) + lane; const f32x4* xr = (const f32x4*)(x + (size_t)(m0 + q) * DM) + lane;
#pragma unroll
            for (int j = 0; j < 4; ++j) { v[q][j] = orow[64 * j]; xv[q][j] = __builtin_nontemporal_load(xr + 64 * j); } }
#pragma unroll
        for (int q = 0; q < 4; ++q) { float s = 0.f; f32x4 f[4];
#pragma unroll
            for (int j = 0; j < 4; ++j) { f[j] = (f32x4){bf_lo(v[q][j].x), bf_hi(v[q][j].x), bf_lo(v[q][j].y), bf_hi(v[q][j].y)}; s += (f[j].x * f[j].x + f[j].y * f[j].y) + (f[j].z * f[j].z + f[j].w * f[j].w); }
            const float r = 1.0f / sqrtf(wave_sum(s, lane) * (1.0f / DM) + EPS);
            f32x4* orow = (f32x4*)(out + (size_t)(m0 + q) * DM) + lane;
#pragma unroll
            for (int j = 0; j < 4; ++j) __builtin_nontemporal_store(xv[q][j] + f[j] * r * gp[j], orow + 64 * j); }
    }
}

__device__ __forceinline__ int crow(int r, int hi) { return (r & 3) + 8 * (r >> 2) + 4 * hi; }

__device__ __forceinline__ void gate_unit(LAS unsigned char* lds, bf16_t* Zg, int ch, const bf16_t* wsb, const float* ln_g, const float* ln_b, const float* b_s, bool dostore = true) {
    int tid_ = threadIdx.x; asm volatile("" : "+v"(tid_));
    const int tid = tid_, lane = tid & 63, r32 = lane & 31, hi = lane >> 5; const int wid = __builtin_amdgcn_readfirstlane(tid >> 6);
    LAS float* stats = (LAS float*)lds;
    LAS bf16_t* vnT = (LAS bf16_t*)(lds + 2048);
    bf16_t* Zc = Zg + (size_t)ch * 128 * ZLD;
    {
        const int row = tid >> 2, part = tid & 3; const bf16_t* src = Zc + (size_t)row * ZLD + COL_VB + part * 8;
        float s = 0.f, s2 = 0.f;
#pragma unroll 8
        for (int i = 0; i < 32; ++i) { const u32x4 w = *(const u32x4*)(src + i * 32);
#pragma unroll
            for (int e = 0; e < 4; ++e) { const float a = bf_lo(w[e]), b = bf_hi(w[e]); s += a + b; s2 += a * a + b * b; } }
        s += shx(s, 1, lane); s += shx(s, 2, lane); s2 += shx(s2, 1, lane); s2 += shx(s2, 2, lane);
        const float mean = s * (1.0f / 1024.0f); const float var = fmaxf(s2 * (1.0f / 1024.0f) - mean * mean, 0.f);
        if (part == 0) { stats[row * 2] = mean; stats[row * 2 + 1] = 1.0f / sqrtf(var + EPS); }
    }
    __syncthreads();
    const int pt = wid >> 1, kt0 = 2 * (wid & 1);
    for (int g = 0; g < 8; ++g) {
#pragma unroll
        for (int i = 0; i < 4; ++i) { const int p = tid + 512 * i, q = p >> 4, c = p & 15; const int col = g * 128 + c * 8;
            const u32x4 w = *(const u32x4*)(Zc + (size_t)q * ZLD + COL_VB + col);
            const float mean = stats[q * 2], rstd = stats[q * 2 + 1];
            const f32x4 g0 = *(const f32x4*)(ln_g + col), g1 = *(const f32x4*)(ln_g + col + 4), b0 = *(const f32x4*)(ln_b + col), b1 = *(const f32x4*)(ln_b + col + 4);
            float v[8] = {bf_lo(w.x), bf_hi(w.x), bf_lo(w.y), bf_hi(w.y), bf_lo(w.z), bf_hi(w.z), bf_lo(w.w), bf_hi(w.w)};
            const float gg[8] = {g0.x, g0.y, g0.z, g0.w, g1.x, g1.y, g1.z, g1.w}, bb[8] = {b0.x, b0.y, b0.z, b0.w, b1.x, b1.y, b1.z, b1.w};
#pragma unroll
            for (int e = 0; e < 8; ++e) vnT[(c * 8 + e) * 136 + q] = (bf16_t)f2bf((v[e] - mean) * rstd * gg[e] + bb[e]); }
        __syncthreads();
        f32x16 acc[2]; acc[0] = f32x16{}; acc[1] = f32x16{};
        const bf16_t* ap = wsb + (size_t)g * 16384 + (32 * pt + r32) * 128 + 8 * hi;
#pragma unroll
        for (int ks = 0; ks < 8; ++ks) { const bf16x8 a = *(const bf16x8*)(ap + 16 * ks);
#pragma unroll
            for (int j = 0; j < 2; ++j) { const bf16x8 b = *(const LAS bf16x8*)(vnT + (32 * (kt0 + j) + r32) * 136 + 16 * ks + 8 * hi);
                acc[j] = __builtin_amdgcn_mfma_f32_32x32x16_bf16(a, b, acc[j], 0, 0, 0); } }
        LAS float* st = (LAS float*)(lds + 40960);
#pragma unroll
        for (int j = 0; j < 2; ++j)
#pragma unroll
            for (int r = 0; r < 16; ++r) { const int p = 32 * pt + crow(r, hi); st[p * 132 + 32 * (kt0 + j) + r32] = acc[j][r] + b_s[g * 128 + p]; }
        __syncthreads();
#pragma unroll
        for (int i = 0; i < 4; ++i) { const int p = (tid >> 4) + 32 * i, c8 = (tid & 15) * 8; bf16_t* zr = Zc + (size_t)p * ZLD + g * 128 + c8;
            const u32x4 uw = *(const u32x4*)(zr + COL_U), gw = *(const u32x4*)(zr + COL_GB);
            const f32x4 s0 = *(const LAS f32x4*)(st + p * 132 + c8), s1 = *(const LAS f32x4*)(st + p * 132 + c8 + 4);
            const float sv[8] = {s0.x, s0.y, s0.z, s0.w, s1.x, s1.y, s1.z, s1.w}; u32x4 ow;
#pragma unroll
            for (int e = 0; e < 4; ++e) { const float u0 = bf_lo(uw[e]), u1 = bf_hi(uw[e]), g0 = bf_lo(gw[e]), g1 = bf_hi(gw[e]);
                ow[e] = cvt_pk_bf16(u0 * sv[2 * e] * g0 * sigmoidf_fast(g0), u1 * sv[2 * e + 1] * g1 * sigmoidf_fast(g1)); }
            if (dostore) *(u32x4*)(zr + COL_U) = ow; }
        __syncthreads();
    }
}

__device__ __forceinline__ s16x4 vtr(const LAS unsigned char* p) { typedef short v4i16_t __attribute__((ext_vector_type(4))); return __builtin_bit_cast(s16x4, __builtin_amdgcn_ds_read_tr16_b64_v4i16((LAS v4i16_t*)p)); }

__device__ __forceinline__ void attn_unit(LAS unsigned char* lds, bf16_t* Zg, const unsigned char* KVg, int S, int b, int h, int qb, const float* lq1, const float* lk1, const float* lq2, const float* lk2, const float* subln_g, const float* rel_bias, bool dostore = true) {
    int tid_ = threadIdx.x; asm volatile("" : "+v"(tid_));
    const int tid = tid_, lane = tid & 63, r32 = lane & 31, hi = lane >> 5; const int wid = __builtin_amdgcn_readfirstlane(tid >> 6);
    const int qsub = wid & 3, mp = wid >> 2;
    const size_t rowbase = (size_t)b * S; const int q0 = qb * 128, qw0 = q0 + 32 * qsub;
    LAS float* tab = (LAS float*)(lds + 131072);
    LAS float* wsf = (LAS float*)(lds + 131072 + 2304) + wid * 32;
    const int NT = S / 64; const size_t tstep = (size_t)64 * ZLD;
    const unsigned char* kvb = KVg + ((size_t)((b * 8 + h) * NT) << 15);
    const __amdgpu_buffer_rsrc_t kvr = __builtin_amdgcn_make_buffer_rsrc((void*)kvb, (short)0, NT << 15, 0x00020000);
    const unsigned kvo = wid * 1024 + lane * 16;
    const unsigned vvo = 16384 + (wid >> 1) * 4096 + (wid & 1) * 2048 + lane * 16;
    const unsigned kdma = wid * 1024, vdma = 65536 + (wid >> 1) * 4096 + (wid & 1) * 2048;
#define DMAB(voff, soff, imm, dstoff) __builtin_amdgcn_raw_ptr_buffer_load_lds(kvr, (LAS void*)(lds + (dstoff)), 16, (voff), (soff), (imm), 0)
#define ISSUE_K(tile, slot) do { const int s_ = (tile) << 15; DMAB(kvo, s_, 0, (slot) * 16384 + kdma); DMAB(kvo, s_ + 8192, 0, (slot) * 16384 + 8192 + kdma); } while (0)
#define ISSUE_V(tile, slot) do { const int s_ = (tile) << 15; DMAB(vvo, s_, 0, (slot) * 16384 + vdma); DMAB(vvo, s_ + 1024, 0, (slot) * 16384 + vdma + 1024); } while (0)
#define STEP_CLOSE() do { asm volatile("s_waitcnt vmcnt(0)" ::: "memory"); asm volatile("s_waitcnt lgkmcnt(0)" ::: "memory"); __builtin_amdgcn_s_barrier(); asm volatile("" ::: "memory"); } while (0)
    ISSUE_K(0, 0); ISSUE_V(0, 0); ISSUE_K(1, 1); ISSUE_K(2, 2); ISSUE_V(1, 1);
    for (int ti = tid; ti < 513; ti += 512) { const int rel = ti - 256, n = rel < 0 ? -rel : rel;
        int bk = n < 8 ? n : n < 12 ? 8 : n < 16 ? 9 : n < 23 ? 10 : n < 32 ? 11 : n < 46 ? 12 : n < 64 ? 13 : n < 91 ? 14 : 15; if (rel > 0) bk += 16;
        tab[ti] = rel_bias[bk * 8 + h] * LOG2E; }
    bf16x8 qr[4];
    { const bf16_t* qp = Zg + (rowbase + qw0 + r32) * ZLD + COL_Q + mp * 512 + h * 64 + hi * 8;
#pragma unroll
      for (int d0 = 0; d0 < 4; ++d0) qr[d0] = *(const bf16x8*)(qp + d0 * 16); }
    asm volatile("s_waitcnt vmcnt(0)" ::: "memory");
    __syncthreads();
    const float c_neg = tab[0], c_pos = tab[512];
    float mhat = 0.f, lsum = 0.f; f32x16 o[4]; o[0] = f32x16{}; o[1] = f32x16{}; o[2] = f32x16{}; o[3] = f32x16{};
    const unsigned vlane = 65536 + (4 * hi + ((lane & 15) >> 2)) * 64 + ((lane >> 4) & 1) * 32 + (lane & 3) * 8;
    unsigned kla[4];
#pragma unroll
    for (int d0 = 0; d0 < 4; ++d0) kla[d0] = mp * 8192 + r32 * 128 + (((2 * d0 + hi) ^ ((r32 >> 1) & 7)) << 4);
    f32x16 cinit;
    f32x16 pA0, pA1, pB0, pB1; u32x4 pw0, pw1, pw2, pw3;
#define SB() __builtin_amdgcn_sched_barrier(0)
#define PEL(P0, P1, idx) ((idx) < 16 ? P0[(idx) & 15] : P1[(idx) & 15])
#define EXPEL(C0, C1, idx) do { if ((idx) < 16) C0[(idx) & 15] = __builtin_amdgcn_exp2f(C0[(idx) & 15]); else C1[(idx) & 15] = __builtin_amdgcn_exp2f(C1[(idx) & 15]); } while (0)
#define VOFF(i) (((i) & 3) * 4096 + ((i) >> 2) * 1024)
#define VTR(dst, off) asm volatile("ds_read_b64_tr_b16 %0, %1 offset:%c2" : "=&v"(dst) : "v"(vbase), "i"(off) : "memory")
#define TILE_CB(k0v) ((((k0v) + 63 - qw0) <= -91) ? c_neg : ((((k0v) - (qw0 + 31)) >= 91) ? c_pos : 0.f))
#define NEAR_BIAS(C0, C1, k0v) do { if (!((((k0v) + 63 - qw0) <= -91) || (((k0v) - (qw0 + 31)) >= 91))) { const LAS float* tp_ = tab + ((k0v) + 4 * hi - (qw0 + r32) + 256);     \
        _Pragma("unroll") for (int r = 0; r < 16; ++r) { C0[r] += tp_[(r & 3) + 8 * (r >> 2)]; C1[r] += tp_[(r & 3) + 8 * (r >> 2) + 32]; } } } while (0)
#define SET_CINIT(k0v) do { const float ci_ = TILE_CB(k0v) - mhat; _Pragma("unroll") for (int r = 0; r < 16; ++r) cinit[r] = ci_; } while (0)
#define RESCALE_O() do { asm volatile("s_waitcnt lgkmcnt(0)" ::: "memory"); \
        _Pragma("unroll") for (int g = 0; g < 4; ++g) { const f32x4 a4 = *(const LAS f32x4*)(wsf + 8 * g + 4 * hi); \
            _Pragma("unroll") for (int db = 0; db < 4; ++db) { o[db][4 * g] *= a4.x; o[db][4 * g + 1] *= a4.y; o[db][4 * g + 2] *= a4.z; o[db][4 * g + 3] *= a4.w; } } } while (0)
    {
        bf16x8 kf_[8]; const LAS unsigned char* kb_ = lds;
#pragma unroll
        for (int i_ = 0; i_ < 4; ++i_) { kf_[2 * i_] = *(const LAS bf16x8*)(kb_ + kla[i_]); kf_[2 * i_ + 1] = *(const LAS bf16x8*)(kb_ + kla[i_] + 4096); }
        SET_CINIT(0);
#pragma unroll
        for (int i_ = 0; i_ < 8; ++i_) { if (i_ & 1) pA1 = __builtin_amdgcn_mfma_f32_32x32x16_bf16(kf_[i_], qr[i_ >> 1], (i_ < 2) ? cinit : pA1, 0, 0, 0);
                                         else        pA0 = __builtin_amdgcn_mfma_f32_32x32x16_bf16(kf_[i_], qr[i_ >> 1], (i_ < 2) ? cinit : pA0, 0, 0, 0); }
        NEAR_BIAS(pA0, pA1, 0);
        float rm_ = fmaxf(pA0[0], pA1[0]);
#pragma unroll
        for (int r = 1; r < 16; ++r) rm_ = fmaxf(fmaxf(rm_, pA0[r]), pA1[r]);
        { auto rr_ = __builtin_amdgcn_permlane32_swap(__float_as_uint(rm_), __float_as_uint(rm_), false, false); rm_ = fmaxf(__uint_as_float(rr_[0]), __uint_as_float(rr_[1])); }
        mhat = rm_;
#pragma unroll
        for (int r = 0; r < 16; ++r) { pA0[r] = __builtin_amdgcn_exp2f(pA0[r] - rm_); pA1[r] = __builtin_amdgcn_exp2f(pA1[r] - rm_); }
        SET_CINIT(64);
        STEP_CLOSE();
    }
#define STEP(HS, ISS, CLS, C0, C1, P0, P1, T, SL) do { \
    const int t_ = (T); const int k0_ = t_ * 64; \
    const int dk_ = ((t_ + 2 < NT) ? t_ + 2 : NT - 1) << 15, dv_ = ((t_ + 1 < NT) ? t_ + 1 : NT - 1) << 15; const unsigned dks_ = (((SL) + 2) & 3) * 16384 + kdma, dvs_ = (((SL) + 1) & 3) * 16384 + vdma;     \
    bf16x8 kf_[8]; \
    const LAS unsigned char* kb_ = lds + (SL) * 16384; \
    if (HS) { \
        _Pragma("unroll") for (int i_ = 0; i_ < 2; ++i_) { kf_[2 * i_] = *(const LAS bf16x8*)(kb_ + kla[i_]); kf_[2 * i_ + 1] = *(const LAS bf16x8*)(kb_ + kla[i_] + 4096); } } \
    SB(); \
    float sacc_ = 0.f; \
    _Pragma("unroll") for (int i_ = 0; i_ < 8; ++i_) { \
        if (HS) { if (i_ < 4) kf_[4 + i_] = *(const LAS bf16x8*)(kb_ + kla[(4 + i_) >> 1] + ((4 + i_) & 1) * 4096); \
                  if (ISS && (CLS)) { if (i_ == 1) DMAB(kvo, dk_, 0, dks_); else if (i_ == 3) DMAB(kvo, dk_ + 8192, 0, dks_ + 8192); else if (i_ == 5) DMAB(vvo, dv_, 0, dvs_); else if (i_ == 7) DMAB(vvo, dv_ + 1024, 0, dvs_ + 1024); } \
                  if (i_ & 1) C1 = __builtin_amdgcn_mfma_f32_32x32x16_bf16(kf_[i_], qr[i_ >> 1], (i_ < 2) ? cinit : C1, 0, 0, 0); \
                  else        C0 = __builtin_amdgcn_mfma_f32_32x32x16_bf16(kf_[i_], qr[i_ >> 1], (i_ < 2) ? cinit : C0, 0, 0, 0); } \
        { const float e0_ = PEL(P0, P1, 4 * i_), e1_ = PEL(P0, P1, 4 * i_ + 1), e2_ = PEL(P0, P1, 4 * i_ + 2), e3_ = PEL(P0, P1, 4 * i_ + 3); \
            sacc_ += (e0_ + e1_) + (e2_ + e3_); const unsigned w0_ = cvt_pk_bf16(e0_, e1_), w1_ = cvt_pk_bf16(e2_, e3_); \
            if ((i_ >> 1) == 0) { pw0[(i_ & 1) * 2] = w0_; pw0[(i_ & 1) * 2 + 1] = w1_; } else if ((i_ >> 1) == 1) { pw1[(i_ & 1) * 2] = w0_; pw1[(i_ & 1) * 2 + 1] = w1_; } \
            else if ((i_ >> 1) == 2) { pw2[(i_ & 1) * 2] = w0_; pw2[(i_ & 1) * 2 + 1] = w1_; } else { pw3[(i_ & 1) * 2] = w0_; pw3[(i_ & 1) * 2 + 1] = w1_; } \
            asm volatile("" : "+v"(sacc_)); if ((i_ >> 1) == 0) asm volatile("" : "+v"(pw0)); else if ((i_ >> 1) == 1) asm volatile("" : "+v"(pw1)); else if ((i_ >> 1) == 2) asm volatile("" : "+v"(pw2)); else asm volatile("" : "+v"(pw3)); } \
        SB(); } \
    lsum += sacc_; \
    if (HS) NEAR_BIAS(C0, C1, k0_); \
    SB(); \
    float mrun_ = -1e30f; \
    s16x4 vl_[16], vh_[16]; const unsigned vbase = (unsigned)(uintptr_t)(lds + (((SL) + 3) & 3) * 16384 + vlane); \
    _Pragma("unroll") for (int i_ = 0; i_ < 3; ++i_) { VTR(vl_[i_], VOFF(i_)); VTR(vh_[i_], VOFF(i_) + 512); } \
    _Pragma("unroll") for (int i_ = 0; i_ < 16; ++i_) { \
        { if (i_ + 3 < 16) { VTR(vl_[i_ + 3], VOFF(i_ + 3)); VTR(vh_[i_ + 3], VOFF(i_ + 3) + 512); } \
            if (i_ <= 12) asm volatile("s_waitcnt lgkmcnt(6)" ::: "memory"); else if (i_ == 13) asm volatile("s_waitcnt lgkmcnt(4)" ::: "memory"); else if (i_ == 14) asm volatile("s_waitcnt lgkmcnt(2)" ::: "memory"); else asm volatile("s_waitcnt lgkmcnt(0)" ::: "memory"); \
            asm volatile("" : "+v"(vl_[i_]), "+v"(vh_[i_])); \
            const bf16x8 vf_ = {vl_[i_][0], vl_[i_][1], vl_[i_][2], vl_[i_][3], vh_[i_][0], vh_[i_][1], vh_[i_][2], vh_[i_][3]}; \
            const bf16x8 pa_ = __builtin_bit_cast(bf16x8, (i_ >> 2) == 0 ? pw0 : (i_ >> 2) == 1 ? pw1 : (i_ >> 2) == 2 ? pw2 : pw3); \
            o[i_ & 3] = __builtin_amdgcn_mfma_f32_32x32x16_bf16(pa_, vf_, o[i_ & 3], 0, 0, 0); } \
        if (HS) { if (ISS && !(CLS)) { if (i_ == 2) DMAB(kvo, dk_, 0, dks_); else if (i_ == 5) DMAB(kvo, dk_ + 8192, 0, dks_ + 8192); else if (i_ == 8) DMAB(vvo, dv_, 0, dvs_); else if (i_ == 11) DMAB(vvo, dv_ + 1024, 0, dvs_ + 1024); }     \
                  mrun_ = fmaxf(fmaxf(mrun_, PEL(C0, C1, 2 * i_)), PEL(C0, C1, 2 * i_ + 1)); EXPEL(C0, C1, 2 * i_); EXPEL(C0, C1, 2 * i_ + 1); \
            asm volatile("" : "+v"(mrun_)); if (i_ < 8) asm volatile("" : "+v"(C0)); else asm volatile("" : "+v"(C1)); } \
        SB(); } \
    if (HS) { \
        { auto rr_ = __builtin_amdgcn_permlane32_swap(__float_as_uint(mrun_), __float_as_uint(mrun_), false, false); mrun_ = fmaxf(__uint_as_float(rr_[0]), __uint_as_float(rr_[1])); } \
        const bool resc_ = __any(mrun_ > 8.0f); \
        if (resc_) { const float dl_ = fmaxf(mrun_, 0.f); mhat += dl_; const float alpha_ = __builtin_amdgcn_exp2f(-dl_); lsum *= alpha_; if (hi == 0) wsf[r32] = alpha_; \
            _Pragma("unroll") for (int r = 0; r < 16; ++r) { C0[r] *= alpha_; C1[r] *= alpha_; } \
            RESCALE_O(); } \
        if (resc_ || (TILE_CB(k0_ + 64) != TILE_CB(k0_))) SET_CINIT(k0_ + 64); \
    } \
    if (CLS) STEP_CLOSE(); \
} while (0)
    if (wid >= 4) __builtin_amdgcn_s_setprio(1);
    int t = 1;
    for (; t + 4 < NT; t += 4) {
        STEP(true, true, false, pB0, pB1, pA0, pA1, t, 1);
        STEP(true, true, true, pA0, pA1, pB0, pB1, t + 1, 2);
        STEP(true, true, false, pB0, pB1, pA0, pA1, t + 2, 3);
        STEP(true, true, true, pA0, pA1, pB0, pB1, t + 3, 0);
    }
    STEP(true, true, false, pB0, pB1, pA0, pA1, NT - 3, 1);
    STEP(true, true, true, pA0, pA1, pB0, pB1, NT - 2, 2);
    STEP(true, false, false, pB0, pB1, pA0, pA1, NT - 1, 3);
    STEP(false, false, false, pA0, pA1, pB0, pB1, NT, 0);
    __builtin_amdgcn_s_setprio(0);
    asm volatile("s_waitcnt vmcnt(0)" ::: "memory");
    __syncthreads();
#undef STEP_CLOSE
#undef ISSUE_V
#undef ISSUE_K
#undef DMAB
#undef STEP
#undef RESCALE_O
#undef SET_CINIT
#undef NEAR_BIAS
#undef TILE_CB
#undef VTR
#undef VOFF
#undef EXPEL
#undef PEL
#undef SB
    { auto rr_ = __builtin_amdgcn_permlane32_swap(__float_as_uint(lsum), __float_as_uint(lsum), false, false); lsum = __uint_as_float(rr_[0]) + __uint_as_float(rr_[1]); }
    const float lam = __builtin_amdgcn_exp2f(LOG2E * wave_sum(lq1[lane] * lk1[lane], lane)) - __builtin_amdgcn_exp2f(LOG2E * wave_sum(lq2[lane] * lk2[lane], lane)) + LAMBDA_INIT;
    if (hi == 0) wsf[r32] = (mp == 1 ? lam : 1.0f) / lsum;
    asm volatile("s_waitcnt lgkmcnt(0)" ::: "memory");
    float inv[16];
#pragma unroll
    for (int g = 0; g < 4; ++g) { const f32x4 a4 = *(const LAS f32x4*)(wsf + 8 * g + 4 * hi); inv[4 * g] = a4.x; inv[4 * g + 1] = a4.y; inv[4 * g + 2] = a4.z; inv[4 * g + 3] = a4.w; }
    LAS float* exch = (LAS float*)lds;
    if (mp == 1) {
#pragma unroll
        for (int db = 0; db < 4; ++db)
#pragma unroll
            for (int r = 0; r < 16; ++r) exch[(32 * qsub + crow(r, hi)) * 128 + db * 32 + r32] = o[db][r] * inv[r];
    }
    __syncthreads();
    if (mp == 0) {
        float ss[16];
#pragma unroll
        for (int r = 0; r < 16; ++r) { float a = 0.f;
#pragma unroll
            for (int db = 0; db < 4; ++db) { const float d = o[db][r] * inv[r] - exch[(32 * qsub + crow(r, hi)) * 128 + db * 32 + r32]; o[db][r] = d; a += d * d; }
            ss[r] = a; }
#pragma unroll
        for (int r = 0; r < 16; ++r) {
#pragma unroll
            for (int sft = 1; sft < 32; sft <<= 1) ss[r] += shx(ss[r], sft, lane);
            ss[r] = (1.0f - LAMBDA_INIT) / sqrtf(ss[r] * (1.0f / 128.0f) + EPS); }
#pragma unroll
        for (int db = 0; db < 4; ++db) { const float sg = subln_g[db * 32 + r32];
#pragma unroll
            for (int r = 0; r < 16; ++r) exch[(32 * qsub + crow(r, hi)) * 128 + db * 32 + r32] = o[db][r] * ss[r] * sg; }
    }
    __syncthreads();
#pragma unroll
    for (int i = 0; i < 4; ++i) { const int p = (tid >> 4) + 32 * i, c8 = (tid & 15) * 8; bf16_t* zp = Zg + (rowbase + q0 + p) * ZLD + COL_GA + h * 128 + c8;
        const u32x4 gw = *(const u32x4*)zp; const f32x4 s0 = *(const LAS f32x4*)(exch + p * 128 + c8), s1 = *(const LAS f32x4*)(exch + p * 128 + c8 + 4);
        const float sv[8] = {s0.x, s0.y, s0.z, s0.w, s1.x, s1.y, s1.z, s1.w}; u32x4 ow;
#pragma unroll
        for (int e = 0; e < 4; ++e) { const float g0 = bf_lo(gw[e]), g1 = bf_hi(gw[e]); ow[e] = cvt_pk_bf16(sv[2 * e] * g0 * sigmoidf_fast(g0), sv[2 * e + 1] * g1 * sigmoidf_fast(g1)); }
        if (dostore) *(u32x4*)zp = ow; }
    __syncthreads();
}


__device__ __forceinline__ void grid_barrier(unsigned* ctr, unsigned target) {
    asm volatile("s_waitcnt vmcnt(0)" ::: "memory");
    __syncthreads();
    if (threadIdx.x == 0) {
        __builtin_amdgcn_fence(__ATOMIC_RELEASE, "agent");
        asm volatile("s_waitcnt vmcnt(0)" ::: "memory");
        __hip_atomic_fetch_add(ctr, 1u, __ATOMIC_RELAXED, __HIP_MEMORY_SCOPE_AGENT);
        unsigned spins = 0;
        while (__hip_atomic_load(ctr, __ATOMIC_RELAXED, __HIP_MEMORY_SCOPE_AGENT) < target) { __builtin_amdgcn_s_sleep(1); if (++spins > (1u << 26)) break; }
        __builtin_amdgcn_fence(__ATOMIC_ACQUIRE, "agent");
        asm volatile("s_waitcnt vmcnt(0)" ::: "memory");
    }
    __syncthreads();
}
__global__ void __launch_bounds__(NTHREADS, 2) fwd_megakernel(Params P, int ph_lo, int ph_hi, int use_sync) {
    extern __shared__ __attribute__((aligned(16))) unsigned char lds_raw[];
    LAS unsigned char* lds = (LAS unsigned char*)lds_raw;
    cg::grid_group grid = cg::this_grid();
    const int wave = __builtin_amdgcn_readfirstlane((int)threadIdx.x >> 6);
    const int G = gridDim.x, bx = blockIdx.x; const int vcu = (G % 8 == 0) ? (bx % 8) * (G / 8) + bx / 8 : bx;
    const int gw = vcu * NWAVES + wave, ngw = G * NWAVES;
    unsigned char* ws = P.ws;
    bf16_t* Win = (bf16_t*)(ws + WS_WIN); bf16_t* Wpa = (bf16_t*)(ws + WS_WPA); bf16_t* Wpb = (bf16_t*)(ws + WS_WPB); bf16_t* Wo = (bf16_t*)(ws + WS_WO);
    bf16_t* Wsb = (bf16_t*)(ws + WS_WSB); float* RS = (float*)(ws + WS_RS); bf16_t* XB = (bf16_t*)(ws + WS_XB); bf16_t* Z = (bf16_t*)(ws + WS_Z); unsigned* BAR = (unsigned*)(ws + WS_BAR);
    int ph = 0;
#define RUN(k) ((k) >= ph_lo && (k) < ph_hi)
#define SEAM() do { if (use_sync && ph >= ph_lo && ph + 1 < ph_hi) { if (ph == 0) grid.sync(); else grid_barrier(BAR, (unsigned)ph * (unsigned)G); } ++ph; } while (0)
    if (RUN(ph)) {
        if (bx == 0 && threadIdx.x == 0) __hip_atomic_store(BAR, 0u, __ATOMIC_RELAXED, __HIP_MEMORY_SCOPE_AGENT);
        LAS float* scr = (LAS float*)(lds + wave * 16384);
        const int lane = fresh_lane(); const int tid = wave * 64 + lane;
        constexpr int I_IN = (DM / 64) * (ZLD / 32), I_SQ = (DM / 64) * (DM / 32), NITEMS = I_IN + 3 * I_SQ;
        for (int it = gw; it < NITEMS; it += ngw) { int r = it;
            if (r < I_IN) { transpose_item(P.w_in, DM, ZLD, Win, P.g_pre, scr, r, lane); continue; } r -= I_IN;
            if (r < I_SQ) { transpose_item(P.w_pa, DM, DM, Wpa, nullptr, scr, r, lane); continue; } r -= I_SQ;
            if (r < I_SQ) { transpose_item(P.w_pb, DM, DM, Wpb, nullptr, scr, r, lane); continue; } r -= I_SQ;
            transpose_item(P.w_o, DM, DM, Wo, nullptr, scr, r, lane); }
        for (int i = (bx * NTHREADS + tid) * 4; i < 8 * 128 * 128; i += G * NTHREADS * 4) { const f32x4 v = *(const f32x4*)(P.w_s + i); u32x2 w; w.x = cvt_pk_bf16(v.x, v.y); w.y = cvt_pk_bf16(v.z, v.w); *(u32x2*)(Wsb + i) = w; }
        phase_a(P.x_prompt, XB, RS, gw, ngw);
    }
    SEAM();
    for (int g = 0; g < NGROUP; ++g) {
        const float* xg = (g == 0) ? P.x_prompt : P.x_sample + (size_t)(g - 1) * GT * DM;
        float* outg = P.out + (size_t)g * GT * DM;
        const int S = (g == 0) ? 16384 : 4096, NB = GT / S;
        if (RUN(ph)) {
            pg8::Gemm gm{XB, Win, GT, ZLD, DM, DM, DM, nullptr, nullptr}; pg8::StaticOrder So; So.init(GT, ZLD, G, bx);
            pg8::EpiInProj E{Z, ZLD, RS, 1024, C2, ws + WS_KV, (g == 0) ? 14 : 12};
            pg8::gemm_phase<pg8::EpiInProj, pg8::StaticOrder, true, true>(lds, gm, So, E);
        }
        SEAM();
        if (RUN(ph)) {
            for (int ch = vcu; ch < GT / 128; ch += G) gate_unit(lds, Z, ch, Wsb, P.ln_g, P.ln_b, P.b_s);
            const int nqb = S / 128, nunits = NB * 8 * nqb;
            for (int u = vcu; u < nunits; u += G) { const int bh = u / nqb, qb = u % nqb; attn_unit(lds, Z, ws + WS_KV, S, bh >> 3, bh & 7, qb, P.lq1, P.lk1, P.lq2, P.lk2, P.subln_g, P.rel_bias); }
        }
        SEAM();
        if (RUN(ph)) {
            pg8::DualOrder So; So.init(GT, DM, G, bx);
            pg8::Gemm gm{Z + COL_GA, Wpa, GT, DM, DM, ZLD, DM, Z + COL_U, Wpb}; pg8::EpiDual E{Z + COL_MA, Z + COL_MB, ZLD, XB, DM};
            pg8::gemm_phase<pg8::EpiDual, pg8::DualOrder, true, true>(lds, gm, So, E);
        }
        SEAM();
        if (RUN(ph)) {
            pg8::Gemm gm{XB, Wo, GT, DM, DM, DM, DM, nullptr, nullptr}; pg8::StaticOrder So; So.init(GT, DM, G, bx);
            pg8::EpiInProj E{Z + COL_Q, ZLD, nullptr, 0, 1.0f, nullptr, 12};
            pg8::gemm_phase<pg8::EpiInProj, pg8::StaticOrder, true, true>(lds, gm, So, E);
        }
        SEAM();
        if (RUN(ph)) {
            phase_f(xg, outg, Z + COL_Q, ZLD, P.g_post, gw, ngw);
            if (g + 1 < NGROUP) phase_a(P.x_sample + (size_t)g * GT * DM, XB, RS, gw, ngw);
        }
        SEAM();
    }
#undef RUN
#undef SEAM
}
constexpr int N_PHASES = 1 + NGROUP * 5;

extern "C" void kernel_launch(void* const* d_in, const int* in_sizes, int n_in, void* d_out, int out_size, void* d_ws, size_t ws_size, hipStream_t stream) {
    static int grid = 0;
    if (grid == 0) {
        if (n_in != 18 || ws_size < WS_END) { fprintf(stderr, "kernel_launch: unexpected n_in %d / ws_size %zu\n", n_in, ws_size); grid = -1; return; }
        int dev = 0, cus = 0, per_cu = 0;
        hipGetDevice(&dev); hipDeviceGetAttribute(&cus, hipDeviceAttributeMultiprocessorCount, dev);
        if (hipFuncSetAttribute((const void*)fwd_megakernel, hipFuncAttributeMaxDynamicSharedMemorySize, LDS_BYTES) != hipSuccess) { fprintf(stderr, "kernel_launch: hipFuncSetAttribute failed\n"); grid = -1; return; }
        if (hipOccupancyMaxActiveBlocksPerMultiprocessor(&per_cu, (const void*)fwd_megakernel, NTHREADS, LDS_BYTES) != hipSuccess || per_cu < 1) { fprintf(stderr, "kernel_launch: occupancy query says %d\n", per_cu); per_cu = 1; }
        (void)hipGetLastError();
        grid = cus * 1;
    }
    if (grid < 0) return;
    Params p{};
    p.x_prompt = (const float*)d_in[0]; p.x_sample = (const float*)d_in[1]; p.g_pre = (const float*)d_in[2]; p.w_in = (const float*)d_in[3];
    p.lq1 = (const float*)d_in[4]; p.lk1 = (const float*)d_in[5]; p.lq2 = (const float*)d_in[6]; p.lk2 = (const float*)d_in[7]; p.subln_g = (const float*)d_in[8];
    p.w_pa = (const float*)d_in[9]; p.ln_g = (const float*)d_in[10]; p.ln_b = (const float*)d_in[11]; p.w_s = (const float*)d_in[12]; p.b_s = (const float*)d_in[13];
    p.w_pb = (const float*)d_in[14]; p.w_o = (const float*)d_in[15]; p.g_post = (const float*)d_in[16]; p.rel_bias = (const float*)d_in[17];
    p.out = (float*)d_out; p.ws = (unsigned char*)d_ws;
#if MK_MULTI
    for (int k = 0; k < N_PHASES; ++k) { int lo = k, hi = k + 1, us = 0; hipLaunchKernelGGL(fwd_megakernel, dim3(grid), dim3(NTHREADS), LDS_BYTES, stream, p, lo, hi, us); }
#else
    int lo = 0, hi = N_PHASES, us = 1;
    void* args[] = {&p, &lo, &hi, &us};
    hipError_t e = hipLaunchCooperativeKernel((const void*)fwd_megakernel, dim3(grid), dim3(NTHREADS), args, LDS_BYTES, stream);
    if (e != hipSuccess) fprintf(stderr, "cooperative launch failed: %s (grid %d)\n", hipGetErrorString(e), grid);
#endif
}
```
